# Optimizing an MI355X kernel written in HIP

```python
import math
import jax, jax.numpy as jnp
from jax import lax
import numpy as np

D_MODEL = 1024
BATCH = 8
SEQ = 2048
DEPTH = 2
DEC_BATCH = 128
DEC_SEQ = 4
PAST_LEN = 16384
PAGE_SIZE = 128

N_MIXERS = 2
N_RET_LAYERS = (DEPTH + 1) // 2
N_REC_LAYERS = DEPTH // 2
RET_HEADS = 4
RET_DK = D_MODEL // RET_HEADS
RET_DV = 2 * D_MODEL // RET_HEADS
RET_QK = RET_HEADS * RET_DK
RET_VDIM = RET_HEADS * RET_DV
RET_CHUNK = 128
ROPE_BASE = 10000.0
D_RNN = 1280
LRU_BLOCKS = 8
LRU_BS = D_RNN // LRU_BLOCKS
CONV_W = 4
LRU_C = 8.0
D_FF = 2816
ALPHA = (2.0 * DEPTH) ** 0.25
BETA = (8.0 * DEPTH) ** -0.25
LN_EPS = 1e-5
GN_EPS = 1e-6

kernel_name = 'retnet_hawk_macaron_deepnorm_step'


def layer_norm(x, g, b):
    xf = x.astype(jnp.float32)
    mu = jnp.mean(xf, -1, keepdims=True)
    var = jnp.mean(jnp.square(xf - mu), -1, keepdims=True)
    return ((xf - mu) * lax.rsqrt(var + LN_EPS) * g + b).astype(x.dtype)


def swiglu(x, w_in, w_out):
    g, u = jnp.split(x @ w_in, 2, axis=-1)
    return (jax.nn.silu(g) * u) @ w_out


def rotary(x, pos):
    half = x.shape[-1] // 2
    inv = ROPE_BASE ** (-jnp.arange(half, dtype=jnp.float32) / half)
    ang = pos.astype(jnp.float32)[:, None] * inv[None, :]
    cos, sin = jnp.cos(ang), jnp.sin(ang)
    x1, x2 = x[..., :half], x[..., half:]
    return jnp.concatenate([x1 * cos - x2 * sin, x1 * sin + x2 * cos], axis=-1)


def retention_log_gamma():
    return jnp.log1p(-jnp.exp2(-5.0 - jnp.arange(RET_HEADS, dtype=jnp.float32)))


def retention_chunkwise(q, k, v, s0):
    B, H, T, dk = q.shape
    dv = v.shape[-1]
    C = math.gcd(T, RET_CHUNK)
    n = T // C
    lg = retention_log_gamma()
    idx = jnp.arange(C, dtype=jnp.float32)
    rel = idx[:, None] - idx[None, :]
    dmask = jnp.where(rel >= 0, jnp.exp(lg[:, None, None] * jnp.maximum(rel, 0.0)), 0.0)
    q_dec = jnp.exp(lg[:, None] * (idx + 1.0))[:, :, None]
    k_dec = jnp.exp(lg[:, None] * (C - 1.0 - idx))[:, :, None]
    chunk_dec = jnp.exp(lg * C)[:, None, None]

    def to_chunks(a):
        return a.reshape(B, H, n, C, a.shape[-1]).transpose(2, 0, 1, 3, 4)

    def step(s, qkv):
        qc, kc, vc = qkv
        scores = jnp.einsum('bhcd,bhed->bhce', qc, kc) * dmask
        o = (jnp.einsum('bhce,bhev->bhcv', scores, vc)
             + jnp.einsum('bhcd,bhdv->bhcv', qc * q_dec, s))
        s = s * chunk_dec + jnp.einsum('bhcd,bhcv->bhdv', kc * k_dec, vc)
        return s, o

    s, o = lax.scan(step, s0, (to_chunks(q), to_chunks(k), to_chunks(v)))
    o = o.transpose(1, 2, 0, 3, 4).reshape(B, H, T, dv)
    return o, s


def retention_mixer(x, pos, s0, w_in, gn_g, w_out):
    B, T, _ = x.shape
    proj = x @ w_in
    q, k, v, g = jnp.split(proj, [RET_QK, 2 * RET_QK, 2 * RET_QK + RET_VDIM], axis=-1)

    def heads(a, d):
        return a.reshape(B, T, RET_HEADS, d).transpose(0, 2, 1, 3).astype(jnp.float32)

    q = rotary(heads(q, RET_DK), pos)
    k = rotary(heads(k, RET_DK), pos) * (RET_DK ** -0.5)
    v = heads(v, RET_DV)
    o, s = retention_chunkwise(q, k, v, s0.astype(jnp.float32))
    mu = jnp.mean(o, -1, keepdims=True)
    var = jnp.mean(jnp.square(o - mu), -1, keepdims=True)
    o = ((o - mu) * lax.rsqrt(var + GN_EPS)).transpose(0, 2, 1, 3).reshape(B, T, RET_VDIM) * gn_g
    y = (jax.nn.silu(g.astype(jnp.float32)) * o).astype(x.dtype) @ w_out
    return y, s


def rglru_mixer(x, conv_buf, h0, w_in, conv_w, conv_b, w_a, b_a, w_i, b_i, lam, w_out):
    B, T, _ = x.shape
    gate_br, xb = jnp.split(x @ w_in, 2, axis=-1)
    gate_br = jax.nn.gelu(gate_br, approximate=True)
    xp = jnp.concatenate([conv_buf.astype(xb.dtype), xb], axis=1)
    xc = conv_b + sum(conv_w[j] * xp[:, j:j + T] for j in range(CONV_W))
    new_buf = xp[:, T:]
    xcb = xc.reshape(B, T, LRU_BLOCKS, LRU_BS)
    r = jax.nn.sigmoid(jnp.einsum('btni,nij->btnj', xcb, w_a).reshape(B, T, D_RNN) + b_a)
    i = jax.nn.sigmoid(jnp.einsum('btni,nij->btnj', xcb, w_i).reshape(B, T, D_RNN) + b_i)
    log_a = -LRU_C * r.astype(jnp.float32) * jax.nn.softplus(-lam.astype(jnp.float32))
    a = jnp.exp(log_a)
    u = jnp.sqrt(-jnp.expm1(2.0 * log_a)) * (i * xc).astype(jnp.float32)

    def step(h, au):
        a_t, u_t = au
        h = a_t * h + u_t
        return h, h

    h_last, hs = lax.scan(step, h0.astype(jnp.float32), (a.transpose(1, 0, 2), u.transpose(1, 0, 2)))
    hs = hs.transpose(1, 0, 2).astype(x.dtype)
    y = (gate_br * hs) @ w_out
    return y, new_buf, h_last


def trunk(x, pos, ret_states, conv_states, lru_states, ln_g, ln_b, ffn1_w_in, ffn1_w_out,
          ffn2_w_in, ffn2_w_out, ret_w_in, ret_gn_g, ret_w_out, rec_w_in, rec_conv_w, rec_conv_b,
          rec_w_a, rec_b_a, rec_w_i, rec_b_i, rec_lam, rec_w_out):
    new_ret, new_conv, new_lru = [], [], []
    for layer in range(DEPTH):
        j = layer // N_MIXERS
        x = layer_norm(ALPHA * x + 0.5 * swiglu(x, ffn1_w_in[layer], ffn1_w_out[layer]),
                       ln_g[layer, 0], ln_b[layer, 0])
        if layer % N_MIXERS == 0:
            m, s = retention_mixer(x, pos, ret_states[j], ret_w_in[j], ret_gn_g[j], ret_w_out[j])
            new_ret.append(s)
        else:
            m, cb, h = rglru_mixer(x, conv_states[j], lru_states[j], rec_w_in[j], rec_conv_w[j],
                                   rec_conv_b[j], rec_w_a[j], rec_b_a[j], rec_w_i[j], rec_b_i[j],
                                   rec_lam[j], rec_w_out[j])
            new_conv.append(cb)
            new_lru.append(h)
        x = layer_norm(ALPHA * x + m, ln_g[layer, 1], ln_b[layer, 1])
        x = layer_norm(ALPHA * x + 0.5 * swiglu(x, ffn2_w_in[layer], ffn2_w_out[layer]),
                       ln_g[layer, 2], ln_b[layer, 2])
    return x, jnp.stack(new_ret), jnp.stack(new_conv), jnp.stack(new_lru)


def setup_inputs(seed: int = 0) -> dict:
    key = jax.random.key(seed)
    ks = jax.random.split(key, 32)
    f32 = jnp.float32
    nrm = lambda k, shape, s: jax.random.normal(k, shape, f32) * s
    u = jax.random.uniform(ks[24], (N_REC_LAYERS, D_RNN), f32, 0.9, 0.999)
    a0 = u ** (1.0 / LRU_C)
    return {
        'x_prompt': nrm(ks[0], (BATCH, SEQ, D_MODEL), 1.0),
        'x_sample': nrm(ks[1], (DEC_BATCH, DEC_SEQ, D_MODEL), 1.0),
        'state_ret': nrm(ks[2], (N_RET_LAYERS, DEC_BATCH, RET_HEADS, RET_DK, RET_DV), 0.5),
        'state_conv': nrm(ks[3], (N_REC_LAYERS, DEC_BATCH, CONV_W - 1, D_RNN), 1.0),
        'state_lru': nrm(ks[4], (N_REC_LAYERS, DEC_BATCH, D_RNN), 0.5),
        'ln_g': 1.0 + nrm(ks[5], (DEPTH, 3, D_MODEL), 0.02),
        'ln_b': nrm(ks[6], (DEPTH, 3, D_MODEL), 0.02),
        'ffn1_w_in': nrm(ks[7], (DEPTH, D_MODEL, 2 * D_FF), D_MODEL ** -0.5),
        'ffn1_w_out': nrm(ks[8], (DEPTH, D_FF, D_MODEL), BETA * D_FF ** -0.5),
        'ffn2_w_in': nrm(ks[9], (DEPTH, D_MODEL, 2 * D_FF), D_MODEL ** -0.5),
        'ffn2_w_out': nrm(ks[10], (DEPTH, D_FF, D_MODEL), BETA * D_FF ** -0.5),
        'ret_w_in': nrm(ks[11], (N_RET_LAYERS, D_MODEL, 2 * RET_QK + 2 * RET_VDIM), D_MODEL ** -0.5),
        'ret_gn_g': 1.0 + nrm(ks[12], (N_RET_LAYERS, RET_VDIM), 0.02),
        'ret_w_out': nrm(ks[13], (N_RET_LAYERS, RET_VDIM, D_MODEL), BETA * RET_VDIM ** -0.5),
        'rec_w_in': nrm(ks[14], (N_REC_LAYERS, D_MODEL, 2 * D_RNN), D_MODEL ** -0.5),
        'rec_conv_w': nrm(ks[15], (N_REC_LAYERS, CONV_W, D_RNN), CONV_W ** -0.5),
        'rec_conv_b': nrm(ks[16], (N_REC_LAYERS, D_RNN), 0.02),
        'rec_w_a': nrm(ks[17], (N_REC_LAYERS, LRU_BLOCKS, LRU_BS, LRU_BS), LRU_BS ** -0.5),
        'rec_b_a': nrm(ks[18], (N_REC_LAYERS, D_RNN), 0.02),
        'rec_w_i': nrm(ks[19], (N_REC_LAYERS, LRU_BLOCKS, LRU_BS, LRU_BS), LRU_BS ** -0.5),
        'rec_b_i': nrm(ks[20], (N_REC_LAYERS, D_RNN), 0.02),
        'rec_lam': jnp.log(a0) - jnp.log1p(-a0),
        'rec_w_out': nrm(ks[21], (N_REC_LAYERS, D_RNN, D_MODEL), BETA * D_RNN ** -0.5),
    }


def reference(x_prompt, x_sample, state_ret, state_conv, state_lru, ln_g, ln_b, ffn1_w_in,
              ffn1_w_out, ffn2_w_in, ffn2_w_out, ret_w_in, ret_gn_g, ret_w_out, rec_w_in,
              rec_conv_w, rec_conv_b, rec_w_a, rec_b_a, rec_w_i, rec_b_i, rec_lam, rec_w_out):
    weights = (ln_g, ln_b, ffn1_w_in, ffn1_w_out, ffn2_w_in, ffn2_w_out, ret_w_in, ret_gn_g,
               ret_w_out, rec_w_in, rec_conv_w, rec_conv_b, rec_w_a, rec_b_a, rec_w_i, rec_b_i,
               rec_lam, rec_w_out)
    bp, tp, _ = x_prompt.shape
    ts = x_sample.shape[1]
    zero_ret = jnp.zeros((N_RET_LAYERS, bp, RET_HEADS, RET_DK, RET_DV), jnp.float32)
    zero_conv = jnp.zeros((N_REC_LAYERS, bp, CONV_W - 1, D_RNN), x_prompt.dtype)
    zero_lru = jnp.zeros((N_REC_LAYERS, bp, D_RNN), jnp.float32)
    pos_prompt = jnp.arange(tp, dtype=jnp.int32)
    y_prompt, ret_p, conv_p, lru_p = trunk(x_prompt, pos_prompt, zero_ret, zero_conv, zero_lru, *weights)
    pos_sample = PAST_LEN + jnp.arange(ts, dtype=jnp.int32)
    y_sample, ret_s, conv_s, lru_s = trunk(x_sample, pos_sample, state_ret, state_conv, state_lru, *weights)
    return (y_prompt, y_sample, ret_p, conv_p, lru_p, ret_s, conv_s, lru_s)
```

```cpp
#include <hip/hip_runtime.h>
#include <hip/hip_cooperative_groups.h>
#include <cstdio>
namespace cg = cooperative_groups;

#ifndef PER_PHASE_LAUNCH
#define PER_PHASE_LAUNCH 0
#endif

#define LAS __attribute__((address_space(3)))
typedef unsigned short bf16_t;
typedef short bf16x8 __attribute__((ext_vector_type(8)));
typedef float f32x4 __attribute__((ext_vector_type(4)));
typedef float f32x2 __attribute__((ext_vector_type(2)));
typedef unsigned u32x2 __attribute__((ext_vector_type(2)));
typedef unsigned u32x4 __attribute__((ext_vector_type(4)));

constexpr int DM = 1024, MP = 16384, MS = 512, MT = 16896, DFF = 2816, NFF = 5632, RV = 2048, NRET = 6144, DRNN = 1280, NREC = 2560;
constexpr float ALPHA = 1.41421356237309515f;
constexpr int NTHR = 512;
constexpr int LDS_BYTES = 161792;

constexpr size_t O_Y = 0, O_RETP = 17301504, O_CONVP = 21495808, O_LRUP = 21526528, O_RETS = 21536768, O_CONVS = 88645632, O_LRUS = 89137152;

constexpr size_t al256(size_t x) { return (x + 255) & ~(size_t)255; }
constexpr size_t SZ_WFIN = (size_t)NFF * DM * 2, SZ_WFOUT = (size_t)DM * DFF * 2;
constexpr size_t WS_WF1IN0 = 0, WS_WF1IN1 = WS_WF1IN0 + SZ_WFIN, WS_WF2IN0 = WS_WF1IN1 + SZ_WFIN, WS_WF2IN1 = WS_WF2IN0 + SZ_WFIN;
constexpr size_t WS_WF1OUT0 = WS_WF2IN1 + SZ_WFIN, WS_WF1OUT1 = WS_WF1OUT0 + SZ_WFOUT, WS_WF2OUT0 = WS_WF1OUT1 + SZ_WFOUT, WS_WF2OUT1 = WS_WF2OUT0 + SZ_WFOUT;
constexpr size_t WS_WRETIN = WS_WF2OUT1 + SZ_WFOUT, WS_WRETOUT = WS_WRETIN + (size_t)NRET * DM * 2, WS_WRECIN = WS_WRETOUT + (size_t)DM * RV * 2;
constexpr size_t WS_WRECOUT = WS_WRECIN + (size_t)NREC * DM * 2, WS_WA = WS_WRECOUT + (size_t)DM * DRNN * 2, WS_WI = WS_WA + al256(8 * 160 * 160 * 2);
constexpr size_t WS_C_F1IN1 = WS_WI + al256(8 * 160 * 160 * 2);
constexpr size_t WS_C_F2IN0 = WS_C_F1IN1 + 2 * NFF * 4, WS_C_F2IN1 = WS_C_F2IN0 + 2 * NFF * 4, WS_C_RETIN = WS_C_F2IN1 + 2 * NFF * 4;
constexpr size_t WS_C_RECIN = WS_C_RETIN + 2 * NRET * 4;
constexpr size_t WS_COS = WS_C_RECIN + 2 * NREC * 4, WS_SIN = WS_COS + 2052 * 128 * 4, WS_COST = WS_SIN + 2052 * 128 * 4, WS_SINT = WS_COST + 128 * 2048 * 4;
constexpr size_t WS_FLAGS = WS_SINT + 128 * 2048 * 4;
constexpr size_t WS_CARRY = WS_FLAGS + 64 * 16 * 64;
constexpr size_t WS_SPL = WS_CARRY + 64 * 16 * 160 * 4;
constexpr size_t WS_BAR = WS_SPL + al256(DRNN * 4);
constexpr size_t WS_STATS = WS_BAR + 2048;
constexpr size_t SZ_STATS = (size_t)MT * 32 * 4;
constexpr size_t WS_XB16 = WS_STATS + 6 * SZ_STATS;
constexpr size_t WS_PRE = WS_XB16 + (size_t)MT * DM * 2;
constexpr size_t WS_ACT = WS_PRE + (size_t)MT * DM * 4;
constexpr size_t A_H = 0;
constexpr size_t A_Q = 0, A_K = A_Q + (size_t)MT * 1024 * 2, A_KT = A_K + (size_t)MT * 1024 * 2, A_VT = A_KT + (size_t)1024 * MP * 2;
constexpr size_t A_VS = A_VT + (size_t)2048 * MP * 2, A_SG = A_VS + (size_t)MS * 2048 * 2, A_O = A_SG + (size_t)MT * 2048 * 2, A_OG = A_O + (size_t)MP * 2048 * 2;
constexpr size_t A_END_RET = A_OG + (size_t)MT * 2048 * 2;
constexpr size_t A_GATE = 0, A_XBR = A_GATE + (size_t)MT * DRNN * 2, A_HG = A_XBR + (size_t)MT * DRNN * 4;
constexpr size_t WS_END = WS_ACT + A_END_RET;

struct Params {
    const float* x_prompt; const float* x_sample; const float* state_ret; const float* state_conv; const float* state_lru;
    const float* ln_g; const float* ln_b; const float* ffn1_w_in; const float* ffn1_w_out; const float* ffn2_w_in; const float* ffn2_w_out;
    const float* ret_w_in; const float* ret_gn_g; const float* ret_w_out; const float* rec_w_in; const float* rec_conv_w; const float* rec_conv_b;
    const float* rec_w_a; const float* rec_b_a; const float* rec_w_i; const float* rec_b_i; const float* rec_lam; const float* rec_w_out;
    float* out; unsigned char* ws; int ph_lo, ph_hi, wv, vb, xcc, nloc, nx, pad;
};

#define otid() otid_(p.wv)
__device__ __forceinline__ int otid_(int wv) { int t = wv * 64 + (int)__builtin_amdgcn_mbcnt_hi(~0u, __builtin_amdgcn_mbcnt_lo(~0u, 0u)); asm volatile("" : "+v"(t)); return t; }
__device__ __forceinline__ unsigned pk_bf16(float lo, float hi) { unsigned r; asm("v_cvt_pk_bf16_f32 %0, %1, %2" : "=v"(r) : "v"(lo), "v"(hi)); return r; }
__device__ __forceinline__ float bf2f(bf16_t b) { return __uint_as_float(((unsigned)b) << 16); }
__device__ __forceinline__ float bflo(unsigned w) { return __uint_as_float(w << 16); }
__device__ __forceinline__ float bfhi(unsigned w) { return __uint_as_float(w & 0xffff0000u); }
__device__ __forceinline__ float sigmoid_(float x) { return __builtin_amdgcn_rcpf(1.0f + __expf(-x)); }
__device__ __forceinline__ float silu_(float x) { return x * sigmoid_(x); }
__device__ __forceinline__ float gelu_tanh_(float x) { return x * sigmoid_(1.5957691216057308f * (x + 0.044715f * x * x * x)); }
__device__ __forceinline__ float one_minus_exp(float x) {
    const float ps = x * (1.f + x * (0.5f + x * (1.f / 6.f + x * (1.f / 24.f + x * (1.f / 120.f + x * (1.f / 720.f + x * (1.f / 5040.f)))))));
    const float e = 1.f - __expf(x);
    return x > -0.5f ? -ps : e;
}
__device__ __forceinline__ f32x4 mfma16(bf16x8 a, bf16x8 b, f32x4 c) { return __builtin_amdgcn_mfma_f32_16x16x32_bf16(a, b, c, 0, 0, 0); }

constexpr int BM = 256, BK = 64, HALF = 128, HTB = HALF * BK * 2, NXCD = 8, WGM = 8;
__device__ __forceinline__ int lds_byte(int r, int c) { const int st = (r >> 4) * 2 + (c >> 5), rr = r & 15, cc = c & 31, ob = rr * 64 + cc * 2; return st * 1024 + (ob ^ (((ob >> 9) & 1) << 5)); }
__device__ __forceinline__ void stage_rc(int b, int& R, int& C) { const int st = b / 1024, sb = b % 1024, swz = sb ^ (((sb >> 9) & 1) << 5); R = (st >> 1) * 16 + swz / 64; C = (st & 1) * 32 + (swz % 64) / 2; }

struct Unit { int pm, pn; };
struct Sched {
    const char* A; const char* B; int nM, nN, nwg, nExtra, K, G, c, mode, upm, upn, ntl, ibase, iend; size_t koff;
    __device__ __forceinline__ void init(const void* A_, const void* B_, int M, int N, int K_, int extra) {
        A = (const char*)A_; B = (const char*)B_; nM = M / BM; nN = N / BM; nwg = nM * nN; nExtra = extra; K = K_; G = gridDim.x; mode = 0; upm = 0; upn = 0; ntl = K_ / BK; ibase = 0; iend = 1 << 20; koff = 0; }
    __device__ __forceinline__ void std_map(int wgid, int nwg_, int nM_, Unit& u) const {
        { const int q = nwg_ / NXCD, r = nwg_ % NXCD, xcd = wgid % NXCD, off = wgid / NXCD; wgid = (xcd < r ? xcd * (q + 1) : r * (q + 1) + (xcd - r) * q) + off; }
        const int nig = WGM * nN, gid = wgid / nig, fm = gid * WGM, gsz = (nM_ - fm) < WGM ? (nM_ - fm) : WGM;
        u.pm = fm + ((wgid % nig) % gsz); u.pn = (wgid % nig) / gsz;
    }
    __device__ __forceinline__ bool next(int i, Unit& u) const {
        i += ibase; if (i >= iend) return false;
        if (mode == 2) { u.pm = upm; u.pn = upn; return i == 0; }
        if (mode == 1) {
            int L;
            if (c >= 248) { if (i >= 3) return false; L = i * 256 + c; }
            else if (i < 5) L = i * 256 + c;
            else if (i == 5) { if (c < 172) L = 1280 + c; else if (c < 188) L = (3 + ((c - 172) & 1)) * 256 + 248 + ((c - 172) >> 1); else return false; }
            else return false;
            if (L < 44) { u.pm = 64 + L / 22; u.pn = L % 22; return true; }
            std_map(L - 44, 1408, 64, u); return true;
        }
        if (mode == 4) {
            const int L4 = i * 256 + c; if (L4 >= 660) return false;
            if (L4 < 20) { u.pm = 64 + L4 / 10; u.pn = L4 % 10; return true; }
            std_map(L4 - 20, 640, 64, u); return true;
        }
        if (mode == 3) {
            const int L3 = i * 256 + c; if (L3 >= 1584) return false;
            if (L3 < 48) { u.pm = 64 + L3 / 24; u.pn = L3 % 24; return true; }
            std_map(L3 - 48, 1536, 64, u); return true;
        }
        const long L = (long)i * G + c; if (L >= nwg + nExtra) return false;
        if (L >= nwg) { const int e = (int)L - nwg; u.pm = e & 63; u.pn = 24 + (e >> 6); return true; }
        std_map((int)L, nwg, nM, u); return true;
    }
};
__device__ __forceinline__ bool unit_swapped(const Unit& u) { return (u.pn >= 24) || (u.pn >= 8 && u.pn < 16 && u.pm < 64); }

template <bool SWAP, class Epi>
__device__ __forceinline__ void gemm_phase(LAS unsigned char* lds, const Sched& S, const Epi& E, const int wv_, unsigned* done_ctr = nullptr) {
    const int tid = otid_(wv_), wid = __builtin_amdgcn_readfirstlane(tid >> 6), lane = tid & 63, wr = wid >> 2, wc = wid & 3, fr = lane & 15, fq = lane >> 4;
    const int K = S.K, nt = S.ntl;
    unsigned voff[2];
#pragma unroll
    for (int i = 0; i < 2; ++i) { int R, C; stage_rc(tid * 16 + i * 8192, R, C); voff[i] = (unsigned)(R * K + C) * 2u; }
    const size_t kstep = (size_t)(BK * 2);
    const size_t hstep = (size_t)HALF * K * 2;
    const size_t tstep = 2 * hstep;
    const unsigned ldsw = (unsigned)wid * 1024u;
    const int aoff = lds_byte(wr * 64 + fr, fq * 8), boff = lds_byte(wc * 32 + fr, fq * 8);
#define G_SA(b, h) (((b) * 2 + (h)) * HTB)
#define G_SB(b, h) ((4 + (b) * 2 + (h)) * HTB)
#define G_STAGE(bufoff, gbase) do { _Pragma("unroll") for (int _i = 0; _i < 2; ++_i) \
        __builtin_amdgcn_global_load_lds((const unsigned*)((const char*)(gbase) + voff[_i]), (LAS unsigned*)(lds + (bufoff) + ldsw + _i * 8192), 16, 0, 0); } while (0)
#define G_LDA(dst, b, h) do { _Pragma("unroll") for (int m = 0; m < 4; ++m) _Pragma("unroll") for (int k = 0; k < 2; ++k) dst[m][k] = *(const LAS bf16x8*)(lds + G_SA(b, h) + aoff + m * 2048 + k * 1024); } while (0)
#define G_LDB(dst, b, h) do { _Pragma("unroll") for (int n = 0; n < 2; ++n) _Pragma("unroll") for (int k = 0; k < 2; ++k) dst[n][k] = *(const LAS bf16x8*)(lds + G_SB(b, h) + boff + n * 2048 + k * 1024); } while (0)
#define G_MMA(ai, bj, At, Bt) do { __builtin_amdgcn_s_setprio(1); _Pragma("unroll") for (int m = 0; m < 4; ++m) _Pragma("unroll") for (int n = 0; n < 2; ++n) _Pragma("unroll") for (int k = 0; k < 2; ++k) \
        acc[ai][bj][m][n] = __builtin_amdgcn_mfma_f32_16x16x32_bf16(Bt[n][k], At[m][k], acc[ai][bj][m][n], 0, 0, 0); __builtin_amdgcn_s_setprio(0); } while (0)
#define G_WAIT_V(n) asm volatile("s_waitcnt vmcnt(" #n ")" ::: "memory")
#define G_WAIT_L(n) asm volatile("s_waitcnt lgkmcnt(" #n ")" ::: "memory")
#define G_BAR __builtin_amdgcn_s_barrier()
#define G_SCHED __builtin_amdgcn_sched_barrier(0)
#define G_PTRS(u, pa, pb) do { if (SWAP && unit_swapped(u)) { const int wpn = (u).pn >= 24 ? (u).pn - 20 : (u).pn; pa = S.B + (size_t)wpn * tstep; pb = S.A + (size_t)(u).pm * tstep; } \
        else { pa = S.A + (size_t)(u).pm * tstep + S.koff; pb = S.B + (size_t)(u).pn * tstep + S.koff; } } while (0)
    Unit cur, nxt; int ui = 0;
    if (!S.next(0, cur)) return;
    f32x4 acc[2][2][4][2];
#pragma unroll
    for (int a = 0; a < 2; ++a)
#pragma unroll
        for (int b = 0; b < 2; ++b)
#pragma unroll
            for (int m = 0; m < 4; ++m)
#pragma unroll
                for (int n = 0; n < 2; ++n) acc[a][b][m][n] = (f32x4){0.f, 0.f, 0.f, 0.f};
    bf16x8 At[4][2], B0[2][2], B1[2][2];
    const char* cA; const char* cB; G_PTRS(cur, cA, cB);
    G_STAGE(G_SB(0, 0), cB); G_STAGE(G_SA(0, 0), cA); G_STAGE(G_SB(0, 1), cB + hstep); G_STAGE(G_SA(0, 1), cA + hstep);
    if (wr == 1) G_BAR;
    G_WAIT_V(4); G_BAR;
    G_STAGE(G_SB(1, 0), cB + kstep); G_STAGE(G_SA(1, 0), cA + kstep); G_STAGE(G_SB(1, 1), cB + hstep + kstep);
    G_WAIT_V(6); G_BAR;
    for (;;) {
        const bool has_next = S.next(ui + 1, nxt);
        const char* nA = cA; const char* nB = cB;
        if (has_next) G_PTRS(nxt, nA, nB);
        for (int t = 0; t < nt; t += 2) {
            const bool last = (t == nt - 2);
            const char* a1 = cA + (size_t)(t + 1) * kstep;
            const char* a2 = last ? nA : cA + (size_t)(t + 2) * kstep; const char* b2 = last ? nB : cB + (size_t)(t + 2) * kstep;
            const char* a3 = a2 + kstep; const char* b3 = b2 + kstep;
            G_LDB(B0, 0, 0); G_SCHED; G_LDA(At, 0, 0); G_STAGE(G_SA(1, 1), a1 + hstep);
            G_WAIT_L(8); G_BAR; G_WAIT_L(0); G_MMA(0, 0, At, B0); G_BAR; G_SCHED;
            G_LDB(B1, 0, 1); G_STAGE(G_SB(0, 0), b2);
            G_BAR; G_WAIT_L(0); G_MMA(0, 1, At, B1); G_BAR;
            G_LDA(At, 0, 1); G_STAGE(G_SA(0, 0), a2);
            G_BAR; G_WAIT_L(0); G_MMA(1, 0, At, B0); G_BAR; G_SCHED;
            G_STAGE(G_SB(0, 1), b2 + hstep);
            G_WAIT_V(6); G_BAR; G_MMA(1, 1, At, B1); G_BAR;
            G_LDB(B0, 1, 0); G_SCHED; G_LDA(At, 1, 0); G_STAGE(G_SA(0, 1), a2 + hstep);
            G_WAIT_L(8); G_BAR; G_WAIT_L(0); G_MMA(0, 0, At, B0); G_BAR; G_SCHED;
            G_LDB(B1, 1, 1); G_STAGE(G_SB(1, 0), b3);
            G_BAR; G_WAIT_L(0); G_MMA(0, 1, At, B1); G_BAR;
            G_LDA(At, 1, 1); G_STAGE(G_SA(1, 0), a3);
            G_BAR; G_WAIT_L(0); G_MMA(1, 0, At, B0); G_BAR; G_SCHED;
            G_STAGE(G_SB(1, 1), b3 + hstep);
            G_WAIT_V(6); G_BAR; G_MMA(1, 1, At, B1); G_BAR;
        }
        E(acc, cur, wr, wc, fr, fq);
        if (done_ctr && cur.pm >= 64) {
            __builtin_amdgcn_fence(__ATOMIC_RELEASE, "agent");
            asm volatile("s_waitcnt vmcnt(0)" ::: "memory");
            if (lane == 0) __hip_atomic_fetch_add(done_ctr, 1u, __ATOMIC_RELAXED, __HIP_MEMORY_SCOPE_AGENT);
        }
        if (!has_next) break;
#pragma unroll
        for (int a = 0; a < 2; ++a)
#pragma unroll
            for (int b = 0; b < 2; ++b)
#pragma unroll
                for (int m = 0; m < 4; ++m)
#pragma unroll
                    for (int n = 0; n < 2; ++n) acc[a][b][m][n] = (f32x4){0.f, 0.f, 0.f, 0.f};
        cur = nxt; cA = nA; cB = nB; ++ui;
    }
    G_WAIT_V(0);
    if (wr == 0) G_BAR;
    G_BAR;
#undef G_SA
#undef G_SB
#undef G_STAGE
#undef G_LDA
#undef G_LDB
#undef G_MMA
#undef G_WAIT_V
#undef G_WAIT_L
#undef G_BAR
#undef G_SCHED
#undef G_PTRS
}

__device__ __forceinline__ void ln_rows(const float* st, int row0, int fq, float (&mu)[2][4], float (&rs)[2][4]) {
#pragma unroll
    for (int ai = 0; ai < 2; ++ai)
#pragma unroll
        for (int m = 0; m < 4; ++m) {
            const float* p = st + (unsigned)((row0 + ai * HALF + m * 16) * 32 + fq * 8);
            const f32x4 a = *(const f32x4*)p, b = *(const f32x4*)(p + 4);
            float s = (a[0] + a[2]) + (b[0] + b[2]), q = (a[1] + a[3]) + (b[1] + b[3]);
            s += __shfl_xor(s, 16); q += __shfl_xor(q, 16); s += __shfl_xor(s, 32); q += __shfl_xor(q, 32);
            const float mean = s * (1.0f / 1024.0f), var = q * (1.0f / 1024.0f) - mean * mean;
            mu[ai][m] = mean; rs[ai][m] = rsqrtf(var + 1e-5f);
            if (m == 3) asm volatile("" ::: "memory");
        }
}
__device__ __forceinline__ void ln_rows4(const float* st, int row0, int fq, float (&mu)[4], float (&rs)[4]) {
#pragma unroll
    for (int m = 0; m < 4; ++m) {
        const float* p = st + (unsigned)((row0 + m * 16) * 32 + fq * 8);
        const f32x4 a = *(const f32x4*)p, b = *(const f32x4*)(p + 4);
        float s = (a[0] + a[2]) + (b[0] + b[2]), q = (a[1] + a[3]) + (b[1] + b[3]);
        s += __shfl_xor(s, 16); q += __shfl_xor(q, 16); s += __shfl_xor(s, 32); q += __shfl_xor(q, 32);
        const float mean = s * (1.0f / 1024.0f), var = q * (1.0f / 1024.0f) - mean * mean;
        mu[m] = mean; rs[m] = rsqrtf(var + 1e-5f);
    }
    asm volatile("" ::: "memory");
}
__device__ __forceinline__ void ln_tok4(const float* st, int tok0, int fr, float (&mu)[4], float (&rs)[4]) {
#pragma unroll
    for (int i = 0; i < 4; ++i) {
        const f32x2 v = *(const f32x2*)(st + (unsigned)((tok0 + i) * 32 + fr * 2));
        float s = v[0], q = v[1];
        s += __shfl_xor(s, 1); q += __shfl_xor(q, 1); s += __shfl_xor(s, 2); q += __shfl_xor(q, 2);
        s += __shfl_xor(s, 4); q += __shfl_xor(q, 4); s += __shfl_xor(s, 8); q += __shfl_xor(q, 8);
        const float mean = s * (1.0f / 1024.0f), var = q * (1.0f / 1024.0f) - mean * mean;
        mu[i] = mean; rs[i] = rsqrtf(var + 1e-5f);
    }
}

struct EpiFfnIn {
    bf16_t* h; const float* st; const float* c1; const float* c2; int ln;
    __device__ __forceinline__ void operator()(const f32x4 (&acc)[2][2][4][2], const Unit& u, int wr, int wc, int fr_, int fq_) const {
        int fr = fr_, fq = fq_; asm volatile("" : "+v"(fr), "+v"(fq));
        const int row0 = u.pm * BM + wr * 64 + fr;
        float mu[2][4], rs[2][4];
        if (ln) ln_rows(st, row0, fq, mu, rs);
#pragma unroll
        for (int n = 0; n < 2; ++n) {
            const int R = u.pn * BM + wc * 32 + n * 16 + fq * 4, hcol = u.pn * HALF + wc * 32 + n * 16 + fq * 4;
            f32x4 c1g = {0.f, 0.f, 0.f, 0.f}, c2g = c1g, c1u = c1g, c2u = c1g;
            if (ln) { c1g = *(const f32x4*)(c1 + R); c2g = *(const f32x4*)(c2 + R); c1u = *(const f32x4*)(c1 + R + HALF); c2u = *(const f32x4*)(c2 + R + HALF); }
#pragma unroll
            for (int ai = 0; ai < 2; ++ai)
#pragma unroll
                for (int m = 0; m < 4; ++m) {
                    f32x4 yg = acc[ai][0][m][n], yu = acc[ai][1][m][n];
                    if (ln) { yg = (yg - c1g * mu[ai][m]) * rs[ai][m] + c2g; yu = (yu - c1u * mu[ai][m]) * rs[ai][m] + c2u; }
                    u32x2 w; w[0] = pk_bf16(silu_(yg[0]) * yu[0], silu_(yg[1]) * yu[1]); w[1] = pk_bf16(silu_(yg[2]) * yu[2], silu_(yg[3]) * yu[3]);
                    *(u32x2*)(h + (size_t)(row0 + ai * HALF + m * 16) * DFF + hcol) = w;
                }
        }
    }
};

template <bool SPLIT> struct EpiOutT {
    float* pre; bf16_t* xb; const float* st_prev; float* st_new; const float* g; const float* b; const float* xp; const float* xs; float scale; int raw;
    __device__ __forceinline__ void operator()(const f32x4 (&acc)[2][2][4][2], const Unit& u, int wr, int wc, int fr_, int fq_) const {
        int fr = fr_, fq = fq_; asm volatile("" : "+v"(fr), "+v"(fq));
        const int row0 = u.pm * BM + wr * 64 + fr, col0 = u.pn * BM + wc * 32 + fq * 4;
        const int tile = (u.pm - 64) * 4 + u.pn;
        const float* mypart = SPLIT ? pre + (size_t)tile * 65536 + (((wr * 4 + wc) * 64 + fq * 16 + fr) * 4) : nullptr;
        unsigned* pflag = (unsigned*)((unsigned char*)xb - WS_XB16 + WS_BAR) + 113 + tile;
        if (SPLIT) {
            while (__hip_atomic_load(pflag, __ATOMIC_RELAXED, __HIP_MEMORY_SCOPE_AGENT) < 8u) __builtin_amdgcn_s_sleep(4);
            __builtin_amdgcn_fence(__ATOMIC_ACQUIRE, "agent"); asm volatile("s_waitcnt vmcnt(0)" ::: "memory");
        }
        float mu[2][4], rs[2][4];
        if (!raw) ln_rows(st_prev, row0, fq, mu, rs);
        float s[2][4], q[2][4];
#pragma unroll
        for (int ai = 0; ai < 2; ++ai)
#pragma unroll
            for (int m = 0; m < 4; ++m) { s[ai][m] = 0.f; q[ai][m] = 0.f; }
        const float* xr = (u.pm < 64) ? xp : xs - (size_t)MP * DM;
#pragma unroll
        for (int bj = 0; bj < 2; ++bj)
#pragma unroll
            for (int n = 0; n < 2; ++n) {
                const int col = col0 + bj * HALF + n * 16;
                f32x4 g4 = {1.f, 1.f, 1.f, 1.f}, b4 = {0.f, 0.f, 0.f, 0.f};
                if (!raw) { g4 = *(const f32x4*)(g + col); b4 = *(const f32x4*)(b + col); }
#pragma unroll
                for (int ai = 0; ai < 2; ++ai)
#pragma unroll
                    for (int m = 0; m < 4; ++m) {
                        const size_t off = (size_t)(row0 + ai * HALF + m * 16) * DM + col;
                        f32x4 r4;
                        if (raw) r4 = *(const f32x4*)(xr + off);
                        else { const u32x2 pw = *(const u32x2*)(xb + off); const f32x4 p4 = {bflo(pw[0]), bfhi(pw[0]), bflo(pw[1]), bfhi(pw[1])}; r4 = (p4 - mu[ai][m]) * rs[ai][m] * g4 + b4; }
                        f32x4 av = acc[ai][bj][m][n];
                        if (SPLIT) av += *(const f32x4*)(mypart + (((ai * 2 + bj) * 4 + m) * 2 + n) * 2048);
                        const f32x4 v = r4 * ALPHA + av * scale;
                        u32x2 w; w[0] = pk_bf16(v[0], v[1]); w[1] = pk_bf16(v[2], v[3]);
                        *(u32x2*)(xb + off) = w;
                        s[ai][m] += (v[0] + v[1]) + (v[2] + v[3]);
                        q[ai][m] += (v[0] * v[0] + v[1] * v[1]) + (v[2] * v[2] + v[3] * v[3]);
                    }
            }
#pragma unroll
        for (int ai = 0; ai < 2; ++ai)
#pragma unroll
            for (int m = 0; m < 4; ++m) {
                float ss = s[ai][m], qq = q[ai][m];
                ss += __shfl_xor(ss, 16); qq += __shfl_xor(qq, 16); ss += __shfl_xor(ss, 32); qq += __shfl_xor(qq, 32);
                if (fq == 0) *(f32x2*)(st_new + (size_t)(row0 + ai * HALF + m * 16) * 32 + (u.pn * 4 + wc) * 2) = (f32x2){ss, qq};
            }
    }
};
typedef EpiOutT<false> EpiOut;


struct EpiPart {
    float* part; unsigned* pflag;
    __device__ __forceinline__ void operator()(const f32x4 (&acc)[2][2][4][2], const Unit& u, int wr, int wc, int fr_, int fq_) const {
        int fr = fr_, fq = fq_; asm volatile("" : "+v"(fr), "+v"(fq));
        float* mypart = part + (((wr * 4 + wc) * 64 + fq * 16 + fr) * 4);
#pragma unroll
        for (int ai = 0; ai < 2; ++ai)
#pragma unroll
            for (int bj = 0; bj < 2; ++bj)
#pragma unroll
                for (int m = 0; m < 4; ++m)
#pragma unroll
                    for (int n = 0; n < 2; ++n) *(f32x4*)(mypart + (((ai * 2 + bj) * 4 + m) * 2 + n) * 2048) = acc[ai][bj][m][n];
        __builtin_amdgcn_fence(__ATOMIC_RELEASE, "agent");
        asm volatile("s_waitcnt vmcnt(0)" ::: "memory");
        if (fr == 0 && fq == 0) __hip_atomic_fetch_add(pflag, 1u, __ATOMIC_RELAXED, __HIP_MEMORY_SCOPE_AGENT);
    }
};

struct EpiRetIn {
    unsigned char* ws;
    __device__ __forceinline__ void operator()(const f32x4 (&acc)[2][2][4][2], const Unit& u, int wr, int wc, int fr_, int fq_) const {
        int fr = fr_, fq = fq_; asm volatile("" : "+v"(fr), "+v"(fq));
        bf16_t* const q = (bf16_t*)(ws + WS_ACT + A_Q); bf16_t* const k = (bf16_t*)(ws + WS_ACT + A_K); bf16_t* const kT = (bf16_t*)(ws + WS_ACT + A_KT);
        bf16_t* const vT = (bf16_t*)(ws + WS_ACT + A_VT); bf16_t* const vs = (bf16_t*)(ws + WS_ACT + A_VS); bf16_t* const sg = (bf16_t*)(ws + WS_ACT + A_SG);
        const float* const st = (const float*)(ws + WS_STATS); const float* const c1 = (const float*)(ws + WS_C_RETIN); const float* const c2 = c1 + NRET;
        const float* const cosn = (const float*)(ws + WS_COS); const float* const sinn = (const float*)(ws + WS_SIN);
        const float* const cost = (const float*)(ws + WS_COST); const float* const sint = (const float*)(ws + WS_SINT);
        if (!unit_swapped(u)) {
            const int row0 = u.pm * BM + wr * 64 + fr;
            if (u.pn < 8) {
                const int hd = u.pn & 3; bf16_t* dst = (u.pn < 4) ? q : k; const float osc = (u.pn < 4) ? 1.0f : 0.0625f;
#pragma unroll
                for (int ai = 0; ai < 2; ++ai) {
                    float mu[4], rs[4]; ln_rows4(st, row0 + ai * HALF, fq, mu, rs);
#pragma unroll
                    for (int n = 0; n < 2; ++n) {
                        const int j = wc * 32 + n * 16 + fq * 4, R = u.pn * BM + j;
                        const f32x4 c1a = *(const f32x4*)(c1 + R), c2a = *(const f32x4*)(c2 + R), c1b = *(const f32x4*)(c1 + R + HALF), c2b = *(const f32x4*)(c2 + R + HALF);
#pragma unroll
                        for (int m = 0; m < 4; ++m) {
                            const int row = row0 + ai * HALF + m * 16;
                            const int tr = row < MP ? (row & 2047) : 2048 + ((row - MP) & 3);
                            const f32x4 cs = *(const f32x4*)(cosn + tr * 128 + j), sn = *(const f32x4*)(sinn + tr * 128 + j);
                            const f32x4 y1 = ((acc[ai][0][m][n] - c1a * mu[m]) * rs[m] + c2a) * osc, y2 = ((acc[ai][1][m][n] - c1b * mu[m]) * rs[m] + c2b) * osc;
                            const f32x4 o1 = y1 * cs - y2 * sn, o2 = y1 * sn + y2 * cs;
                            u32x2 w1, w2; w1[0] = pk_bf16(o1[0], o1[1]); w1[1] = pk_bf16(o1[2], o1[3]); w2[0] = pk_bf16(o2[0], o2[1]); w2[1] = pk_bf16(o2[2], o2[3]);
                            bf16_t* pq = dst + (size_t)row * 1024 + hd * 256 + j;
                            *(u32x2*)pq = w1; *(u32x2*)(pq + HALF) = w2;
                            if (u.pn >= 4 && u.pm < 64) {
                                const float kdv = __builtin_amdgcn_exp2f((float)(127 - (row & 127)) * __builtin_amdgcn_logf(1.0f - __builtin_amdgcn_exp2f(-5.0f - (float)hd)));
                                bf16_t* pk = kT + (size_t)(hd * 256 + j) * MP + row;
#pragma unroll
                                for (int i = 0; i < 4; ++i) {
                                    pk[(size_t)i * MP] = (bf16_t)(pk_bf16(o1[i] * kdv, 0.f) & 0xffffu);
                                    pk[(size_t)(HALF + i) * MP] = (bf16_t)(pk_bf16(o2[i] * kdv, 0.f) & 0xffffu);
                                }
                            }
                            if (m & 1) asm volatile("" ::: "memory");
                        }
                    }
                }
            } else {
                const bool isv = u.pn < 16;
                bf16_t* dst = isv ? vs - (size_t)MP * 2048 + (size_t)(u.pn - 8) * BM : sg + (size_t)(u.pn - 16) * BM;
#pragma unroll
                for (int ai = 0; ai < 2; ++ai) {
                    float mu[4], rs[4]; ln_rows4(st, row0 + ai * HALF, fq, mu, rs);
#pragma unroll
                    for (int bj = 0; bj < 2; ++bj)
#pragma unroll
                        for (int n = 0; n < 2; ++n) {
                            const int cc = bj * HALF + wc * 32 + n * 16 + fq * 4, R = u.pn * BM + cc;
                            const f32x4 c1a = *(const f32x4*)(c1 + R), c2a = *(const f32x4*)(c2 + R);
#pragma unroll
                            for (int m = 0; m < 4; ++m) {
                                const int row = row0 + ai * HALF + m * 16;
                                f32x4 y = (acc[ai][bj][m][n] - c1a * mu[m]) * rs[m] + c2a;
                                if (!isv) { y[0] = silu_(y[0]); y[1] = silu_(y[1]); y[2] = silu_(y[2]); y[3] = silu_(y[3]); }
                                u32x2 w; w[0] = pk_bf16(y[0], y[1]); w[1] = pk_bf16(y[2], y[3]);
                                *(u32x2*)(dst + (size_t)row * 2048 + cc) = w;
                            }
                            asm volatile("" ::: "memory");
                        }
                }
            }
        } else {
            const int wpn = u.pn >= 24 ? u.pn - 20 : u.pn;
            const int Rl = wr * 64 + fr;
            if (u.pn >= 24) {
                const int hd = u.pn - 24;
                const float l2g = log2f(1.0f - exp2f(-5.0f - (float)hd));
#pragma unroll
                for (int bj = 0; bj < 2; ++bj)
#pragma unroll
                    for (int n = 0; n < 2; ++n) {
                        const int tok0 = u.pm * BM + bj * HALF + wc * 32 + n * 16 + fq * 4;
                        float mu[4], rs[4]; ln_tok4(st, tok0, fr, mu, rs);
                        const int pos0 = tok0 & 2047;
                        f32x4 kd;
#pragma unroll
                        for (int i = 0; i < 4; ++i) kd[i] = 0.0625f * exp2f((float)(127 - ((pos0 + i) & 127)) * l2g);
                        const f32x4 mu4 = {mu[0], mu[1], mu[2], mu[3]}, rs4 = {rs[0], rs[1], rs[2], rs[3]};
#pragma unroll
                        for (int m = 0; m < 4; ++m) {
                            const int j = Rl + m * 16, Ra = wpn * BM + j;
                            const float c1a = c1[Ra], c2a = c2[Ra], c1b = c1[Ra + HALF], c2b = c2[Ra + HALF];
                            const f32x4 cs = *(const f32x4*)(cost + j * 2048 + pos0), sn = *(const f32x4*)(sint + j * 2048 + pos0);
                            const f32x4 y1 = (acc[0][bj][m][n] - mu4 * c1a) * rs4 + c2a, y2 = (acc[1][bj][m][n] - mu4 * c1b) * rs4 + c2b;
                            const f32x4 o1 = (y1 * cs - y2 * sn) * kd, o2 = (y1 * sn + y2 * cs) * kd;
                            u32x2 w1, w2; w1[0] = pk_bf16(o1[0], o1[1]); w1[1] = pk_bf16(o1[2], o1[3]); w2[0] = pk_bf16(o2[0], o2[1]); w2[1] = pk_bf16(o2[2], o2[3]);
                            *(u32x2*)(kT + (size_t)(hd * 256 + j) * MP + tok0) = w1;
                            *(u32x2*)(kT + (size_t)(hd * 256 + HALF + j) * MP + tok0) = w2;
                            if (m & 1) asm volatile("" ::: "memory");
                        }
                    }
            } else {
                float c1v[2][4], c2v[2][4];
#pragma unroll
                for (int ai = 0; ai < 2; ++ai)
#pragma unroll
                    for (int m = 0; m < 4; ++m) { const int Ra = wpn * BM + ai * HALF + Rl + m * 16; c1v[ai][m] = c1[Ra]; c2v[ai][m] = c2[Ra]; }
#pragma unroll
                for (int bj = 0; bj < 2; ++bj)
#pragma unroll
                    for (int n = 0; n < 2; ++n) {
                        const int tok0 = u.pm * BM + bj * HALF + wc * 32 + n * 16 + fq * 4;
                        float mu[4], rs[4]; ln_tok4(st, tok0, fr, mu, rs);
                        const f32x4 mu4 = {mu[0], mu[1], mu[2], mu[3]}, rs4 = {rs[0], rs[1], rs[2], rs[3]};
#pragma unroll
                        for (int ai = 0; ai < 2; ++ai)
#pragma unroll
                            for (int m = 0; m < 4; ++m) {
                                const int rl = ai * HALF + Rl + m * 16;
                                const f32x4 y = (acc[ai][bj][m][n] - mu4 * c1v[ai][m]) * rs4 + c2v[ai][m];
                                u32x2 w; w[0] = pk_bf16(y[0], y[1]); w[1] = pk_bf16(y[2], y[3]);
                                *(u32x2*)(vT + (size_t)((u.pn - 8) * BM + rl) * MP + tok0) = w;
                            }
                        asm volatile("" ::: "memory");
                    }
            }
        }
    }
};

struct EpiRecIn {
    bf16_t* gate; float* xbr; float* out; const float* st; const float* c1; const float* c2;
    __device__ __forceinline__ void operator()(const f32x4 (&acc)[2][2][4][2], const Unit& u, int wr, int wc, int fr_, int fq_) const {
        int fr = fr_, fq = fq_; asm volatile("" : "+v"(fr), "+v"(fq));
        const int row0 = u.pm * BM + wr * 64 + fr;
        float mu[2][4], rs[2][4];
        ln_rows(st, row0, fq, mu, rs);
        const bool isg = u.pn < 5;
#pragma unroll
        for (int bj = 0; bj < 2; ++bj)
#pragma unroll
            for (int n = 0; n < 2; ++n) {
                const int R = u.pn * BM + bj * HALF + wc * 32 + n * 16 + fq * 4;
                const f32x4 c1a = *(const f32x4*)(c1 + R), c2a = *(const f32x4*)(c2 + R);
#pragma unroll
                for (int ai = 0; ai < 2; ++ai)
#pragma unroll
                    for (int m = 0; m < 4; ++m) {
                        const int row = row0 + ai * HALF + m * 16;
                        f32x4 y = (acc[ai][bj][m][n] - c1a * mu[ai][m]) * rs[ai][m] + c2a;
                        if (isg) {
                            u32x2 w; w[0] = pk_bf16(gelu_tanh_(y[0]), gelu_tanh_(y[1])); w[1] = pk_bf16(gelu_tanh_(y[2]), gelu_tanh_(y[3]));
                            *(u32x2*)(gate + (size_t)row * DRNN + R) = w;
                        } else {
                            const int ch = R - DRNN;
                            *(f32x4*)(xbr + (size_t)row * DRNN + ch) = y;
                            if (row < MP) { const int t = row & 2047; if (t >= 2045) *(f32x4*)(out + O_CONVP + (size_t)((row >> 11) * 3 + (t - 2045)) * DRNN + ch) = y; }
                            else { const int sr = row - MP, t = sr & 3; if (t >= 1) *(f32x4*)(out + O_CONVS + (size_t)((sr >> 2) * 3 + (t - 1)) * DRNN + ch) = y; }
                        }
                    }
            }
    }
};

__device__ __forceinline__ void prep_wtask(const float* W, int K, int N, int n0, int k0, int klen, bf16_t* Bt, int rbase, const float* g, const float* b, float* c1, float* c2, LAS unsigned char* lds, const int tid) {
    const int cn = tid & 63, kr = tid >> 6;
    LAS bf16_t* T = (LAS bf16_t*)lds;
    LAS float* red = (LAS float*)(lds + 16640);
    float c1a = 0.f, c2a = 0.f;
    float v[16], vn[16];
#pragma unroll
    for (int kk = 0; kk < 16; ++kk) v[kk] = W[(size_t)(k0 + kk * 8 + kr) * N + n0 + cn];
    for (int kb = k0; kb < k0 + klen; kb += 128) {
        if (kb + 128 < k0 + klen) {
#pragma unroll
            for (int kk = 0; kk < 16; ++kk) vn[kk] = W[(size_t)(kb + 128 + kk * 8 + kr) * N + n0 + cn];
        }
#pragma unroll
        for (int kk = 0; kk < 16; ++kk) {
            const int row = kb + kk * 8 + kr;
            float wv = v[kk];
            if (g) { wv = v[kk] * g[row]; c2a += v[kk] * b[row]; }
            const unsigned r = pk_bf16(wv, wv) & 0xffffu;
            if (g) c1a += __uint_as_float(r << 16);
            T[cn * 130 + kk * 8 + kr] = (bf16_t)r;
        }
        __syncthreads();
#pragma unroll
        for (int h2 = 0; h2 < 2; ++h2) {
            const int orow = tid >> 3, ch = (tid & 7) + h2 * 8;
            const LAS unsigned* src = (const LAS unsigned*)(T + orow * 130 + ch * 8);
            u32x4 w; w[0] = src[0]; w[1] = src[1]; w[2] = src[2]; w[3] = src[3];
            *(u32x4*)(Bt + (size_t)(rbase + orow) * K + kb + ch * 8) = w;
        }
        __syncthreads();
#pragma unroll
        for (int kk = 0; kk < 16; ++kk) v[kk] = vn[kk];
    }
    if (g) {
        red[kr * 64 + cn] = c1a; red[512 + kr * 64 + cn] = c2a;
        __syncthreads();
        if (tid < 64) { float s1 = 0.f, s2 = 0.f;
#pragma unroll
            for (int r = 0; r < 8; ++r) { s1 += red[r * 64 + tid]; s2 += red[512 + r * 64 + tid]; }
            c1[rbase + tid] = s1; c2[rbase + tid] = s2; }
        __syncthreads();
    }
}
__device__ __forceinline__ int ffn_rowmap(int n0) { return n0 < DFF ? (n0 >> 7) * 256 + (n0 & 127) : ((n0 - DFF) >> 7) * 256 + 128 + ((n0 - DFF) & 127); }

__device__ __forceinline__ int prep_decode(int list, int a) {
    if (list == 1) {
        if (a < 88) return a;
        if (a < 176) return 176 + (a - 88);
        if (a < 208) return 488 + (a - 176);
        if (a < 240) return 552 + (a - 208);
        if (a < 240 + 2625) return 680 + (a - 240);
        return 4105;
    }
    if (list == 2) {
        if (a < 88) return 88 + a;
        if (a < 176) return 264 + (a - 88);
        if (a < 216) return 448 + (a - 176);
        if (a < 248) return 520 + (a - 216);
        if (a < 280) return 584 + (a - 248);
        if (a < 312) return 648 + (a - 280);
        if (a < 344) return 616 + (a - 312);
        return 3305 + (a - 344);
    }
    if (list == 3) return 352 + a;
    return a;
}
__device__ __forceinline__ void phase_prep(const Params& p, LAS unsigned char* lds, const int list, const int first, const int stride) {
    unsigned char* ws = p.ws;
    const int tid = otid();
    constexpr int T_FIN = 88 * 4, T_RETIN = 96, T_RECIN = 40, T_FOUT = 16 * 2 * 4, T_RETOUT = 32, T_RECOUT = 32;
    constexpr int T_W = T_FIN + T_RETIN + T_RECIN + T_FOUT + T_RETOUT + T_RECOUT;
    constexpr int T_X = (MT * DM) / 8192;
    constexpr int T_ROPE = 513, T_WAI = 800, T_MISC = 1;
    constexpr int T_ALL = T_W + T_X + T_ROPE + T_WAI + T_MISC;
    const int n_tasks = list == 0 ? T_ALL : list == 1 ? 2866 : list == 2 ? 1144 : 96;
    for (int a_ = first; a_ < n_tasks; a_ += stride) {
        const int t = prep_decode(list, a_);
        if (t < T_W) {
            int q = t;
            if (q < T_FIN) {
                const int w = q / 88, nt = q % 88;
                const float* W = (w < 2 ? p.ffn1_w_in : p.ffn2_w_in) + (size_t)(w & 1) * DM * NFF;
                bf16_t* Bt = (bf16_t*)(ws + (w == 0 ? WS_WF1IN0 : w == 1 ? WS_WF1IN1 : w == 2 ? WS_WF2IN0 : WS_WF2IN1));
                const float* g = nullptr; const float* b = nullptr; float* c1 = nullptr;
                if (w == 1) { g = p.ln_g + (0 * 3 + 2) * DM; b = p.ln_b + (0 * 3 + 2) * DM; c1 = (float*)(ws + WS_C_F1IN1); }
                if (w == 2) { g = p.ln_g + (0 * 3 + 1) * DM; b = p.ln_b + (0 * 3 + 1) * DM; c1 = (float*)(ws + WS_C_F2IN0); }
                if (w == 3) { g = p.ln_g + (1 * 3 + 1) * DM; b = p.ln_b + (1 * 3 + 1) * DM; c1 = (float*)(ws + WS_C_F2IN1); }
                prep_wtask(W, DM, NFF, nt * 64, 0, DM, Bt, ffn_rowmap(nt * 64), g, b, c1, c1 + NFF, lds, tid);
                continue;
            }
            q -= T_FIN;
            if (q < T_RETIN) { float* c1 = (float*)(ws + WS_C_RETIN);
                prep_wtask(p.ret_w_in, DM, NRET, q * 64, 0, DM, (bf16_t*)(ws + WS_WRETIN), q * 64, p.ln_g + 0, p.ln_b + 0, c1, c1 + NRET, lds, tid); continue; }
            q -= T_RETIN;
            if (q < T_RECIN) { float* c1 = (float*)(ws + WS_C_RECIN);
                prep_wtask(p.rec_w_in, DM, NREC, q * 64, 0, DM, (bf16_t*)(ws + WS_WRECIN), q * 64, p.ln_g + 3 * DM, p.ln_b + 3 * DM, c1, c1 + NREC, lds, tid); continue; }
            q -= T_RECIN;
            if (q < T_FOUT) {
                const int w = q / 32, r = q % 32, nt = r / 2, kc = r % 2;
                const float* W = (w < 2 ? p.ffn1_w_out : p.ffn2_w_out) + (size_t)(w & 1) * DFF * DM;
                bf16_t* Bt = (bf16_t*)(ws + (w == 0 ? WS_WF1OUT0 : w == 1 ? WS_WF1OUT1 : w == 2 ? WS_WF2OUT0 : WS_WF2OUT1));
                prep_wtask(W, DFF, DM, nt * 64, kc * 1408, 1408, Bt, nt * 64, nullptr, nullptr, nullptr, nullptr, lds, tid); continue;
            }
            q -= T_FOUT;
            if (q < T_RETOUT) { prep_wtask(p.ret_w_out, RV, DM, (q >> 1) * 64, (q & 1) * 1024, 1024, (bf16_t*)(ws + WS_WRETOUT), (q >> 1) * 64, nullptr, nullptr, nullptr, nullptr, lds, tid); continue; }
            q -= T_RETOUT;
            prep_wtask(p.rec_w_out, DRNN, DM, (q >> 1) * 64, (q & 1) * 640, 640, (bf16_t*)(ws + WS_WRECOUT), (q >> 1) * 64, nullptr, nullptr, nullptr, nullptr, lds, tid);
            continue;
        }
        int q = t - T_W;
        if (q < T_X) {
            const size_t e0 = (size_t)q * 8192 + (size_t)tid * 16;
            const float* src = e0 < (size_t)MP * DM ? p.x_prompt + e0 : p.x_sample + (e0 - (size_t)MP * DM);
            const f32x4 a = *(const f32x4*)src, b = *(const f32x4*)(src + 4), c = *(const f32x4*)(src + 8), d = *(const f32x4*)(src + 12);
            u32x4 w0, w1; w0[0] = pk_bf16(a[0], a[1]); w0[1] = pk_bf16(a[2], a[3]); w0[2] = pk_bf16(b[0], b[1]); w0[3] = pk_bf16(b[2], b[3]);
            w1[0] = pk_bf16(c[0], c[1]); w1[1] = pk_bf16(c[2], c[3]); w1[2] = pk_bf16(d[0], d[1]); w1[3] = pk_bf16(d[2], d[3]);
            bf16_t* dst = (bf16_t*)(ws + WS_XB16) + e0;
            *(u32x4*)dst = w0; *(u32x4*)(dst + 8) = w1;
            continue;
        }
        q -= T_X;
        if (q < T_ROPE) {
            const int tr = q * 4 + (tid >> 7), j = tid & 127;
            const int pos = tr < 2048 ? tr : 16384 + (tr - 2048);
            const float inv = exp2f(-(float)j * (13.287712379549449f / 128.0f));
            const float ang = (float)pos * inv;
            const double ad = (double)ang, nn = rint(ad * 0.15915494309189535), rr = ad - nn * 6.283185307179586;
            const float rf = (float)rr, cv = cosf(rf), sv = sinf(rf);
            ((float*)(ws + WS_COS))[tr * 128 + j] = cv; ((float*)(ws + WS_SIN))[tr * 128 + j] = sv;
            if (tr < 2048) { ((float*)(ws + WS_COST))[j * 2048 + tr] = cv; ((float*)(ws + WS_SINT))[j * 2048 + tr] = sv; }
            continue;
        }
        q -= T_ROPE;
        if (q < T_WAI) {
            const int e = q * 512 + tid;
            const int mat = e / 204800, r = e % 204800, nb = r / 25600, r2 = r % 25600, jj = r2 / 160, ii = r2 % 160;
            const float v = (mat ? p.rec_w_i : p.rec_w_a)[(size_t)nb * 25600 + ii * 160 + jj];
            ((bf16_t*)(ws + (mat ? WS_WI : WS_WA)))[(size_t)nb * 25600 + jj * 160 + ii] = (bf16_t)(pk_bf16(v, v) & 0xffffu);
            continue;
        }
        for (int i = tid; i < 64 * 16 * 16; i += NTHR) ((unsigned*)(ws + WS_FLAGS))[i] = 0u;
        for (int i = tid; i < DRNN; i += NTHR) { const float z = -p.rec_lam[i]; ((float*)(ws + WS_SPL))[i] = 8.0f * (fmaxf(z, 0.f) + log1pf(__expf(-fabsf(z)))); }
    }
}

__device__ __forceinline__ void ret_prompt_unit(const Params& p, int u, LAS unsigned char* lds) {
    const int tid = otid(), wid = tid >> 6, lane = tid & 63, fr = lane & 15, fq = lane >> 4;
    const int b = u >> 5, hd = (u >> 3) & 3, js = u & 7;
    const float l2g = log2f(1.0f - exp2f(-5.0f - (float)hd));
    constexpr int QH = 0, KH = 34816, KT = 0, ST = 69632, PP = 103424, VT = 138240;
    unsigned char* ws = p.ws;
    for (int i = tid; i < 33792 / 16; i += NTHR) *(LAS u32x4*)(lds + ST + i * 16) = (u32x4){0u, 0u, 0u, 0u};
    f32x4 S[2][4];
#pragma unroll
    for (int a = 0; a < 2; ++a)
#pragma unroll
        for (int c = 0; c < 4; ++c) S[a][c] = (f32x4){0.f, 0.f, 0.f, 0.f};
    const bf16_t* qg = (const bf16_t*)(ws + WS_ACT + A_Q) + (size_t)(b * 2048) * 1024 + hd * 256;
    const bf16_t* kg = (const bf16_t*)(ws + WS_ACT + A_K) + (size_t)(b * 2048) * 1024 + hd * 256;
    const bf16_t* ktg = (const bf16_t*)(ws + WS_ACT + A_KT) + (size_t)(hd * 256) * MP + b * 2048;
    const bf16_t* vtg = (const bf16_t*)(ws + WS_ACT + A_VT) + (size_t)(hd * 512 + js * 64) * MP + b * 2048;
    bf16_t* og = (bf16_t*)(ws + WS_ACT + A_O) + (size_t)(b * 2048) * 2048 + hd * 512 + js * 64;
    const int wm = wid >> 1, wn = wid & 1;
    const int sw = (((fr >> 2) ^ (fr >> 3)) & 1) << 4;
    const float cd = exp2f(128.0f * l2g);
    const float gam_inv = exp2f(-l2g); const float ginv[4] = {1.0f, gam_inv, gam_inv * gam_inv, gam_inv * gam_inv * gam_inv};
    u32x4 rq[4], rk[4], rv[2];
    const int lr = tid >> 4, lc = tid & 15;
    const int lcs = (lc * 16) ^ ((((lr >> 2) ^ (lr >> 3)) & 1) << 4);
#define RET_LD_QK(T0_, hh_) do { _Pragma("unroll") for (int it = 0; it < 4; ++it) { \
        rq[it] = *(const u32x4*)(qg + (size_t)((T0_) + lr + it * 32) * 1024 + (hh_) * 128 + lc * 8); \
        rk[it] = *(const u32x4*)(kg + (size_t)((T0_) + lr + it * 32) * 1024 + (hh_) * 128 + lc * 8); } } while (0)
#define RET_ST_QK() do { _Pragma("unroll") for (int it = 0; it < 4; ++it) { \
        *(LAS u32x4*)(lds + QH + (lr + it * 32) * 272 + lcs) = rq[it]; *(LAS u32x4*)(lds + KH + (lr + it * 32) * 272 + lcs) = rk[it]; } } while (0)
#define RET_LD_VT(T0_) do { _Pragma("unroll") for (int it = 0; it < 2; ++it) rv[it] = *(const u32x4*)(vtg + (size_t)(lr + it * 32) * MP + (T0_) + lc * 8); } while (0)
#define RET_ST_VT() do { _Pragma("unroll") for (int it = 0; it < 2; ++it) *(LAS u32x4*)(lds + VT + (lr + it * 32) * 272 + lcs) = rv[it]; } while (0)
#define RET_LD_KT(T0_) do { _Pragma("unroll") for (int it = 0; it < 4; ++it) { \
        rq[it] = *(const u32x4*)(ktg + (size_t)(lr + it * 32) * MP + (T0_) + lc * 8); rk[it] = *(const u32x4*)(ktg + (size_t)(128 + lr + it * 32) * MP + (T0_) + lc * 8); } } while (0)
#define RET_ST_KT() do { _Pragma("unroll") for (int it = 0; it < 4; ++it) { \
        *(LAS u32x4*)(lds + KT + (lr + it * 32) * 272 + lcs) = rq[it]; *(LAS u32x4*)(lds + KT + (128 + lr + it * 32) * 272 + lcs) = rk[it]; } } while (0)
    RET_LD_QK(0, 0); RET_LD_VT(0);
    __syncthreads();
    for (int c = 0; c < 16; ++c) {
        const int T0 = c * 128;
        f32x4 Pa[2][4], O1[2][2];
#pragma unroll
        for (int a = 0; a < 2; ++a) {
#pragma unroll
            for (int d = 0; d < 4; ++d) Pa[a][d] = (f32x4){0.f, 0.f, 0.f, 0.f};
            O1[a][0] = (f32x4){0.f, 0.f, 0.f, 0.f}; O1[a][1] = (f32x4){0.f, 0.f, 0.f, 0.f};
        }
        for (int hh = 0; hh < 2; ++hh) {
            RET_ST_QK();
            if (hh == 0) RET_ST_VT();
            __syncthreads();
            if (hh == 0) RET_LD_QK(T0, 1); else RET_LD_KT(T0);
#pragma unroll 1
            for (int ks = 0; ks < 4; ++ks) {
                bf16x8 qf[2], kf[4], sf[2];
#pragma unroll
                for (int mt = 0; mt < 2; ++mt) qf[mt] = *(const LAS bf16x8*)(lds + QH + (32 * wm + 16 * mt + fr) * 272 + ((ks * 64 + fq * 16) ^ sw));
#pragma unroll
                for (int nt = 0; nt < 4; ++nt) kf[nt] = *(const LAS bf16x8*)(lds + KH + (64 * wn + 16 * nt + fr) * 272 + ((ks * 64 + fq * 16) ^ sw));
#pragma unroll
                for (int n2 = 0; n2 < 2; ++n2) sf[n2] = *(const LAS bf16x8*)(lds + ST + (32 * wn + 16 * n2 + fr) * 528 + (((hh * 128 + ks * 32) * 2 + fq * 16) ^ sw));
#pragma unroll
                for (int mt = 0; mt < 2; ++mt) {
#pragma unroll
                    for (int nt = 0; nt < 4; ++nt) Pa[mt][nt] = mfma16(kf[nt], qf[mt], Pa[mt][nt]);
#pragma unroll
                    for (int n2 = 0; n2 < 2; ++n2) O1[mt][n2] = mfma16(sf[n2], qf[mt], O1[mt][n2]);
                }
            }
            __syncthreads();
        }
        int dl = 32 * wm + fr - 64 * wn - 4 * fq;
        asm volatile("" : "+v"(dl));
        {
            float rf[2], cf[4];
#pragma unroll
            for (int mt = 0; mt < 2; ++mt) rf[mt] = __builtin_amdgcn_exp2f((float)(32 * wm + 16 * mt + fr) * l2g);
#pragma unroll
            for (int nt = 0; nt < 4; ++nt) cf[nt] = __builtin_amdgcn_exp2f(-(float)(64 * wn + 16 * nt + 4 * fq) * l2g);
#pragma unroll
            for (int mt = 0; mt < 2; ++mt)
#pragma unroll
                for (int nt = 0; nt < 4; ++nt) {
                    const int cc = 32 * wm + 16 * mt + fr, e0 = 64 * wn + 16 * nt + 4 * fq;
                    const float rc = rf[mt] * cf[nt];
                    float v[4];
#pragma unroll
                    for (int i = 0; i < 4; ++i) { const int d = dl + 16 * mt - 16 * nt - i; v[i] = d >= 0 ? Pa[mt][nt][i] * (rc * ginv[i]) : 0.f; }
                    u32x2 w; w[0] = pk_bf16(v[0], v[1]); w[1] = pk_bf16(v[2], v[3]);
                    *(LAS u32x2*)(lds + PP + cc * 272 + ((e0 * 2) ^ sw)) = w;
                }
        }
        RET_ST_KT();
        __syncthreads();
        if (c < 15) { RET_LD_QK(T0 + 128, 0); RET_LD_VT(T0 + 128); }
#pragma unroll
        for (int mt = 0; mt < 2; ++mt) { const float qd = exp2f((float)(32 * wm + 16 * mt + fr + 1) * l2g); O1[mt][0] *= qd; O1[mt][1] *= qd; }
#pragma unroll
        for (int a = 0; a < 2; ++a)
#pragma unroll
            for (int d = 0; d < 4; ++d) S[a][d] *= cd;
#pragma unroll 1
        for (int ks = 0; ks < 4; ++ks) {
            bf16x8 pf[2], vf[2], af[2], bfr[4];
#pragma unroll
            for (int mt = 0; mt < 2; ++mt) pf[mt] = *(const LAS bf16x8*)(lds + PP + (32 * wm + 16 * mt + fr) * 272 + ((ks * 64 + fq * 16) ^ sw));
#pragma unroll
            for (int n2 = 0; n2 < 2; ++n2) vf[n2] = *(const LAS bf16x8*)(lds + VT + (32 * wn + 16 * n2 + fr) * 272 + ((ks * 64 + fq * 16) ^ sw));
#pragma unroll
            for (int mt = 0; mt < 2; ++mt) af[mt] = *(const LAS bf16x8*)(lds + KT + (32 * wid + 16 * mt + fr) * 272 + ((ks * 64 + fq * 16) ^ sw));
#pragma unroll
            for (int nt = 0; nt < 4; ++nt) bfr[nt] = *(const LAS bf16x8*)(lds + VT + (16 * nt + fr) * 272 + ((ks * 64 + fq * 16) ^ sw));
#pragma unroll
            for (int mt = 0; mt < 2; ++mt) {
#pragma unroll
                for (int n2 = 0; n2 < 2; ++n2) O1[mt][n2] = mfma16(vf[n2], pf[mt], O1[mt][n2]);
#pragma unroll
                for (int nt = 0; nt < 4; ++nt) S[mt][nt] = mfma16(af[mt], bfr[nt], S[mt][nt]);
            }
        }
#pragma unroll
        for (int mt = 0; mt < 2; ++mt)
#pragma unroll
            for (int n2 = 0; n2 < 2; ++n2) {
                u32x2 w; w[0] = pk_bf16(O1[mt][n2][0], O1[mt][n2][1]); w[1] = pk_bf16(O1[mt][n2][2], O1[mt][n2][3]);
                *(u32x2*)(og + (size_t)(T0 + 32 * wm + 16 * mt + fr) * 2048 + 32 * wn + 16 * n2 + 4 * fq) = w;
            }
#pragma unroll
        for (int mt = 0; mt < 2; ++mt)
#pragma unroll
            for (int nt = 0; nt < 4; ++nt) {
                u32x2 w; w[0] = pk_bf16(S[mt][nt][0], S[mt][nt][1]); w[1] = pk_bf16(S[mt][nt][2], S[mt][nt][3]);
                *(LAS u32x2*)(lds + ST + (16 * nt + fr) * 528 + (((32 * wid + 16 * mt + 4 * fq) * 2) ^ sw)) = w;
            }
        __syncthreads();
    }
#undef RET_LD_QK
#undef RET_ST_QK
#undef RET_LD_VT
#undef RET_ST_VT
#undef RET_LD_KT
#undef RET_ST_KT
    int soff = ((b * 4 + hd) * 256 + 32 * wid + 4 * fq) * 512 + js * 64 + fr;
    asm volatile("" : "+v"(soff));
    float* so = p.out + O_RETP + soff;
#pragma unroll
    for (int mt = 0; mt < 2; ++mt)
#pragma unroll
        for (int nt = 0; nt < 4; ++nt)
#pragma unroll
            for (int i = 0; i < 4; ++i) so[(16 * mt + i) * 512 + 16 * nt] = S[mt][nt][i];
}

template <int UNR>
__device__ __forceinline__ void ret_sample_unit(const Params& p, int u, LAS unsigned char* lds) {
    const int tid = otid(), wid = tid >> 6, lane = tid & 63;
    const int b = u >> 2, hd = u & 3;
    unsigned char* ws = p.ws;
    const float gam = 1.0f - exp2f(-5.0f - (float)hd);
    LAS float* qs = (LAS float*)lds;
    LAS float* ks = qs + 1024;
    LAS float* red = ks + 1024;
    LAS float* sc = red + 8192;
    LAS float* gs = sc + 16;
    const bf16_t* qg = (const bf16_t*)(ws + WS_ACT + A_Q) + (size_t)(MP + b * 4) * 1024 + hd * 256;
    const bf16_t* kg = (const bf16_t*)(ws + WS_ACT + A_K) + (size_t)(MP + b * 4) * 1024 + hd * 256;
    for (int i = tid; i < 1024; i += NTHR) { const int t = i >> 8, d = i & 255; qs[i] = bf2f(qg[(size_t)t * 1024 + d]); ks[i] = bf2f(kg[(size_t)t * 1024 + d]); }
    __syncthreads();
    {
        const int pair = tid >> 5, t = pair >> 2, e = pair & 3, l = tid & 31;
        float s = 0.f;
#pragma unroll
        for (int d = 0; d < 8; ++d) s += qs[t * 256 + l + d * 32] * ks[e * 256 + l + d * 32];
        s += __shfl_xor(s, 1); s += __shfl_xor(s, 2); s += __shfl_xor(s, 4); s += __shfl_xor(s, 8); s += __shfl_xor(s, 16);
        if (l == 0) { float dm = 0.f; if (e <= t) { dm = 1.f; for (int i = 0; i < t - e; ++i) dm *= gam; } sc[pair] = s * dm; }
    }
    const int cgi = tid & 127, rg = tid >> 7;
    const bf16_t* vg = (const bf16_t*)(ws + WS_ACT + A_VS) + (size_t)(b * 4) * 2048 + hd * 512 + cgi * 4;
    f32x4 v[4];
#pragma unroll
    for (int t = 0; t < 4; ++t) { const u32x2 w = *(const u32x2*)(vg + (size_t)t * 2048); v[t] = (f32x4){bflo(w[0]), bfhi(w[0]), bflo(w[1]), bfhi(w[1])}; }
    const float g2 = gam * gam, g3 = g2 * gam, g4 = g2 * g2;
    const float qdec[4] = {gam, g2, g3, g4}, kdec[4] = {g3, g2, gam, 1.0f};
    const float* s0 = p.state_ret + (size_t)((b * 4 + hd) * 256) * 512 + cgi * 4;
    float* sn = p.out + O_RETS + (size_t)((b * 4 + hd) * 256) * 512 + cgi * 4;
    f32x4 oa[4];
#pragma unroll
    for (int t = 0; t < 4; ++t) oa[t] = (f32x4){0.f, 0.f, 0.f, 0.f};
    {
        f32x4 bA[UNR], bB[UNR];
        const float* sp = s0 + (size_t)(rg * 64) * 512; float* dp = sn + (size_t)(rg * 64) * 512;
#define RS_LOAD(buf, base) do { _Pragma("unroll") for (int j = 0; j < UNR; ++j) buf[j] = __builtin_nontemporal_load((const f32x4*)(sp + (size_t)((base) + j) * 512)); } while (0)
#define RS_PROC(buf, base) do { _Pragma("unroll") for (int j = 0; j < UNR; ++j) { const int d = rg * 64 + (base) + j; const f32x4 s4 = buf[j]; f32x4 n4 = s4 * g4; \
            _Pragma("unroll") for (int t = 0; t < 4; ++t) { oa[t] += s4 * (qs[t * 256 + d] * qdec[t]); n4 += v[t] * (ks[t * 256 + d] * kdec[t]); } \
            __builtin_nontemporal_store(n4, (f32x4*)(dp + (size_t)((base) + j) * 512)); } } while (0)
        RS_LOAD(bA, 0);
#pragma unroll 1
        for (int base = 0; base < 64; base += 2 * UNR) {
            RS_LOAD(bB, base + UNR);
            RS_PROC(bA, base);
            if (base + 2 * UNR < 64) RS_LOAD(bA, base + 2 * UNR);
            RS_PROC(bB, base + UNR);
        }
#undef RS_LOAD
#undef RS_PROC
    }
#pragma unroll
    for (int t = 0; t < 4; ++t) *(LAS f32x4*)(red + (rg * 4 + t) * 512 + cgi * 4) = oa[t];
    __syncthreads();
    const int t = rg;
    f32x4 o4 = *(const LAS f32x4*)(red + (0 * 4 + t) * 512 + cgi * 4);
#pragma unroll
    for (int r = 1; r < 4; ++r) o4 += *(const LAS f32x4*)(red + (r * 4 + t) * 512 + cgi * 4);
#pragma unroll
    for (int e = 0; e < 4; ++e) o4 += v[e] * sc[t * 4 + e];
    float s = (o4[0] + o4[1]) + (o4[2] + o4[3]);
#pragma unroll
    for (int m = 1; m < 64; m <<= 1) s += __shfl_xor(s, m);
    if (lane == 0) gs[wid] = s;
    __syncthreads();
    const float mean = (gs[2 * t] + gs[2 * t + 1]) * (1.0f / 512.0f);
    const f32x4 dv = o4 - mean;
    float qv = (dv[0] * dv[0] + dv[1] * dv[1]) + (dv[2] * dv[2] + dv[3] * dv[3]);
#pragma unroll
    for (int m = 1; m < 64; m <<= 1) qv += __shfl_xor(qv, m);
    if (lane == 0) gs[8 + wid] = qv;
    __syncthreads();
    const float rstd = rsqrtf((gs[8 + 2 * t] + gs[8 + 2 * t + 1]) * (1.0f / 512.0f) + 1e-6f);
    const int row = MP + b * 4 + t, col = hd * 512 + cgi * 4;
    const f32x4 gg = *(const f32x4*)(p.ret_gn_g + col);
    const u32x2 sw = *(const u32x2*)((const bf16_t*)(ws + WS_ACT + A_SG) + (size_t)row * 2048 + col);
    const f32x4 sgv = {bflo(sw[0]), bfhi(sw[0]), bflo(sw[1]), bfhi(sw[1])};
    const f32x4 y = dv * rstd * gg * sgv;
    u32x2 w; w[0] = pk_bf16(y[0], y[1]); w[1] = pk_bf16(y[2], y[3]);
    *(u32x2*)((bf16_t*)(ws + WS_ACT + A_OG) + (size_t)row * 2048 + col) = w;
    __syncthreads();
}

__device__ __forceinline__ void phase_gn(const Params& p) {
    unsigned char* ws = p.ws;
    const int tid = otid(), wid = tid >> 6, lane = tid & 63;
    const bf16_t* o = (const bf16_t*)(ws + WS_ACT + A_O); const bf16_t* sg = (const bf16_t*)(ws + WS_ACT + A_SG); bf16_t* og = (bf16_t*)(ws + WS_ACT + A_OG);
    const int nb = gridDim.x == 256 ? 240 : (int)gridDim.x;
    for (int t0 = (p.vb * 8 + wid) * 4; t0 < MP * 4; t0 += nb * 32) {
        u32x4 ow[4], sw[4]; size_t off[4];
#pragma unroll
        for (int r = 0; r < 4; ++r) { const int t = t0 + r; off[r] = (size_t)(t >> 2) * 2048 + (t & 3) * 512 + lane * 8; ow[r] = *(const u32x4*)(o + off[r]); sw[r] = *(const u32x4*)(sg + off[r]); }
#pragma unroll
        for (int r = 0; r < 4; ++r) {
            const int hd = (t0 + r) & 3;
            float x[8];
#pragma unroll
            for (int i = 0; i < 4; ++i) { x[2 * i] = bflo(ow[r][i]); x[2 * i + 1] = bfhi(ow[r][i]); }
            float s = 0.f;
#pragma unroll
            for (int i = 0; i < 8; ++i) s += x[i];
#pragma unroll
            for (int m = 1; m < 64; m <<= 1) s += __shfl_xor(s, m);
            const float mean = s * (1.0f / 512.0f);
            float q = 0.f;
#pragma unroll
            for (int i = 0; i < 8; ++i) { x[i] -= mean; q += x[i] * x[i]; }
#pragma unroll
            for (int m = 1; m < 64; m <<= 1) q += __shfl_xor(q, m);
            const float rstd = rsqrtf(q * (1.0f / 512.0f) + 1e-6f);
            const f32x4 g0 = *(const f32x4*)(p.ret_gn_g + hd * 512 + lane * 8), g1 = *(const f32x4*)(p.ret_gn_g + hd * 512 + lane * 8 + 4);
            u32x4 w;
#pragma unroll
            for (int i = 0; i < 4; ++i) {
                const float ga = i < 2 ? g0[2 * i] : g1[2 * i - 4], gb = i < 2 ? g0[2 * i + 1] : g1[2 * i - 3];
                w[i] = pk_bf16(x[2 * i] * rstd * ga * bflo(sw[r][i]), x[2 * i + 1] * rstd * gb * bfhi(sw[r][i]));
            }
            *(u32x4*)(og + off[r]) = w;
        }
    }
}

__device__ __forceinline__ void rglru_unit(const Params& p, int u, LAS unsigned char* lds) {
    const int tid = otid(), wid = tid >> 6, lane = tid & 63, fr = lane & 15, fq = lane >> 4;
    unsigned char* ws = p.ws;
    constexpr int XA = 0, WA = 43008, WI = 96768, SUM = 150528, HIN = 160768, OUTB = 43008;
    const bool samp = u >= 1024;
    int nb, row_base, chain = 0, cidx = 0;
    if (!samp) { cidx = u >> 6; chain = u & 63; nb = chain & 7; row_base = (chain >> 3) * 2048 + cidx * 128; }
    else { const int su = u - 1024; nb = su & 7; row_base = MP + (su >> 3) * 128; }
    const float* xbr = (const float*)(ws + WS_ACT + A_XBR);
    {
        const bf16_t* wa = (const bf16_t*)(ws + WS_WA) + (size_t)nb * 25600; const bf16_t* wi = (const bf16_t*)(ws + WS_WI) + (size_t)nb * 25600;
        u32x4 ra[7], ri[7];
#pragma unroll
        for (int it = 0; it < 7; ++it) { const int i = tid + it * NTHR; if (i < 3200) { ra[it] = *(const u32x4*)(wa + i * 8); ri[it] = *(const u32x4*)(wi + i * 8); } }
#pragma unroll
        for (int it = 0; it < 7; ++it) { const int i = tid + it * NTHR; if (i < 3200) { const int r = i / 20, ch = i % 20;
            *(LAS u32x4*)(lds + WA + r * 336 + ch * 16) = ra[it]; *(LAS u32x4*)(lds + WI + r * 336 + ch * 16) = ri[it]; } }
    }
    if (tid < 480) {
        const int c4 = tid % 40, rg = tid / 40, ch = nb * 160 + c4 * 4, r0 = rg * 11;
        f32x4 xin[14];
#pragma unroll
        for (int j = 0; j < 14; ++j) {
            const int r = r0 + j - 3, row = row_base + r;
            f32x4 x = {0.f, 0.f, 0.f, 0.f};
            if (r < 128) {
                if (!samp) { if ((row_base & 2047) + r >= 0) x = *(const f32x4*)(xbr + (size_t)row * DRNN + ch); }
                else if (r >= 0) x = *(const f32x4*)(xbr + (size_t)row * DRNN + ch);
            }
            xin[j] = x;
        }
        const f32x4 cb = *(const f32x4*)(p.rec_conv_b + ch);
        f32x4 cw[4];
#pragma unroll
        for (int j = 0; j < 4; ++j) cw[j] = *(const f32x4*)(p.rec_conv_w + j * DRNN + ch);
#pragma unroll
        for (int k = 0; k < 11; ++k) {
            const int r = r0 + k;
            if (r < 128) {
                f32x4 a = cb;
                if (!samp) {
#pragma unroll
                    for (int j = 0; j < 4; ++j) a += cw[j] * xin[k + j];
                } else {
                    const int sr = row_base - MP + r, t = sr & 3, bb = sr >> 2;
#pragma unroll
                    for (int j = 0; j < 4; ++j) {
                        const int tj = t + j;
                        f32x4 x = xin[k + j];
                        if (tj < 3) x = *(const f32x4*)(p.state_conv + (size_t)(bb * 3 + tj) * DRNN + ch);
                        a += cw[j] * x;
                    }
                }
                u32x2 w2; w2[0] = pk_bf16(a[0], a[1]); w2[1] = pk_bf16(a[2], a[3]);
                *(LAS u32x2*)(lds + XA + r * 336 + c4 * 8) = w2;
            }
        }
    }
    __syncthreads();
    f32x4 ga[10], gi[10];
#pragma unroll
    for (int n = 0; n < 10; ++n) { ga[n] = (f32x4){0.f, 0.f, 0.f, 0.f}; gi[n] = (f32x4){0.f, 0.f, 0.f, 0.f}; }
#pragma unroll 1
    for (int ks = 0; ks < 5; ++ks) {
        const bf16x8 af = *(const LAS bf16x8*)(lds + XA + (16 * wid + fr) * 336 + ks * 64 + fq * 16);
#pragma unroll
        for (int n = 0; n < 10; ++n) {
            const bf16x8 ba = *(const LAS bf16x8*)(lds + WA + (16 * n + fr) * 336 + ks * 64 + fq * 16);
            const bf16x8 bi = *(const LAS bf16x8*)(lds + WI + (16 * n + fr) * 336 + ks * 64 + fq * 16);
            ga[n] = mfma16(af, ba, ga[n]); gi[n] = mfma16(af, bi, gi[n]);
        }
    }
#pragma unroll
    for (int n = 0; n < 10; ++n) {
        const int ch = 16 * n + fr, gch = nb * 160 + ch;
        const float ba = p.rec_b_a[gch], bi = p.rec_b_i[gch], spl = ((const float*)(ws + WS_SPL))[gch];
        float hinit = 0.f;
        if (samp) hinit = p.state_lru[(size_t)(((row_base - MP) >> 2) + 4 * wid + fq) * DRNN + gch];
        float Ac = 1.f, hc = hinit;
#pragma unroll
        for (int i = 0; i < 4; ++i) {
            const float r = sigmoid_(ga[n][i] + ba), ig = sigmoid_(gi[n][i] + bi);
            const float la = -spl * r, a = __expf(la);
            const float xc = bf2f(*(const LAS bf16_t*)(lds + XA + (16 * wid + 4 * fq + i) * 336 + ch * 2));
            const float uu = __builtin_amdgcn_sqrtf(fmaxf(__builtin_fmaf(-a, a, 1.0f), 0.f)) * (ig * xc);
            hc = a * hc + uu; Ac = a * Ac;
            ga[n][i] = Ac; gi[n][i] = hc;
        }
        asm volatile("" ::: "memory");
    }
    if (samp) {
#pragma unroll
        for (int n = 0; n < 10; ++n) p.out[O_LRUS + (size_t)(((row_base - MP) >> 2) + 4 * wid + fq) * DRNN + nb * 160 + 16 * n + fr] = gi[n][3];
    } else {
#pragma unroll
        for (int n = 0; n < 10; ++n) {
            float Ac = 1.f, hc = 0.f;
#pragma unroll
            for (int g = 0; g < 3; ++g) {
                const float Ag = __shfl(ga[n][3], g * 16 + fr), hg = __shfl(gi[n][3], g * 16 + fr);
                if (g < fq) { hc = Ag * hc + hg; Ac = Ag * Ac; }
            }
#pragma unroll
            for (int i = 0; i < 4; ++i) { gi[n][i] += ga[n][i] * hc; ga[n][i] *= Ac; }
            if (fq == 3) *(LAS f32x2*)(lds + SUM + ((wid * 160) + 16 * n + fr) * 8) = (f32x2){ga[n][3], gi[n][3]};
        }
        __syncthreads();
#pragma unroll
        for (int n = 0; n < 10; ++n) {
            float Ac = 1.f, hc = 0.f;
            for (int w = 0; w < wid; ++w) { const f32x2 sv = *(const LAS f32x2*)(lds + SUM + ((w * 160) + 16 * n + fr) * 8); hc = sv[0] * hc + sv[1]; Ac = sv[0] * Ac; }
#pragma unroll
            for (int i = 0; i < 4; ++i) { gi[n][i] += ga[n][i] * hc; ga[n][i] *= Ac; }
        }
        unsigned* flags = (unsigned*)(ws + WS_FLAGS); float* carry = (float*)(ws + WS_CARRY);
        if (tid < 160) {
            float Ac = 1.f, hc = 0.f;
            for (int w = 0; w < 8; ++w) { const f32x2 sv = *(const LAS f32x2*)(lds + SUM + ((w * 160) + tid) * 8); hc = sv[0] * hc + sv[1]; Ac = sv[0] * Ac; }
            float hin = 0.f;
            if (cidx > 0) {
                while (__hip_atomic_load(flags + (chain * 16 + cidx - 1) * 16, __ATOMIC_RELAXED, __HIP_MEMORY_SCOPE_AGENT) == 0u) __builtin_amdgcn_s_sleep(1);
                hin = __hip_atomic_load(carry + (size_t)(chain * 16 + cidx - 1) * 160 + tid, __ATOMIC_RELAXED, __HIP_MEMORY_SCOPE_AGENT);
            }
            const float hout = hc + Ac * hin;
            __hip_atomic_store(carry + (size_t)(chain * 16 + cidx) * 160 + tid, hout, __ATOMIC_RELAXED, __HIP_MEMORY_SCOPE_AGENT);
            *(LAS float*)(lds + HIN + tid * 4) = hin;
            if (cidx == 15) p.out[O_LRUP + (size_t)(chain >> 3) * DRNN + nb * 160 + tid] = hout;
        }
        asm volatile("s_waitcnt vmcnt(0)" ::: "memory");
        __syncthreads();
        if (tid == 0) __hip_atomic_store(flags + (chain * 16 + cidx) * 16, 1u, __ATOMIC_RELAXED, __HIP_MEMORY_SCOPE_AGENT);
#pragma unroll
        for (int n = 0; n < 10; ++n) { const float hin = *(const LAS float*)(lds + HIN + (16 * n + fr) * 4);
#pragma unroll
            for (int i = 0; i < 4; ++i) gi[n][i] += ga[n][i] * hin; }
    }
    __syncthreads();
#pragma unroll
    for (int n = 0; n < 10; ++n)
#pragma unroll
        for (int i = 0; i < 4; ++i) *(LAS float*)(lds + OUTB + ((16 * wid + 4 * fq + i) * 164 + 16 * n + fr) * 4) = gi[n][i];
    __syncthreads();
    {
        const bf16_t* gate = (const bf16_t*)(ws + WS_ACT + A_GATE); bf16_t* hg = (bf16_t*)(ws + WS_ACT + A_HG);
        for (int e = tid; e < 128 * 20; e += NTHR) {
            const int r = e / 20, c8 = e % 20; const size_t off = (size_t)(row_base + r) * DRNN + nb * 160 + c8 * 8;
            const u32x4 gw = *(const u32x4*)(gate + off);
            const f32x4 h0 = *(const LAS f32x4*)(lds + OUTB + (r * 164 + c8 * 8) * 4), h1 = *(const LAS f32x4*)(lds + OUTB + (r * 164 + c8 * 8 + 4) * 4);
            u32x4 w; w[0] = pk_bf16(h0[0] * bflo(gw[0]), h0[1] * bfhi(gw[0])); w[1] = pk_bf16(h0[2] * bflo(gw[1]), h0[3] * bfhi(gw[1]));
            w[2] = pk_bf16(h1[0] * bflo(gw[2]), h1[1] * bfhi(gw[2])); w[3] = pk_bf16(h1[2] * bflo(gw[3]), h1[3] * bfhi(gw[3]));
            *(u32x4*)(hg + off) = w;
        }
    }
    __syncthreads();
}

__device__ __forceinline__ void phase_final_ln(const Params& p) {
    const int tid = otid(), wid = tid >> 6, lane = tid & 63;
    const bf16_t* xb = (const bf16_t*)(p.ws + WS_XB16);
    const float* g = p.ln_g + 5 * DM; const float* b = p.ln_b + 5 * DM;
    for (int row = p.vb * 8 + wid; row < MT; row += gridDim.x * 8) {
        float x[16]; float s = 0.f;
#pragma unroll
        for (int k = 0; k < 2; ++k) { const u32x4 w = *(const u32x4*)(xb + (size_t)row * DM + k * 512 + lane * 8);
#pragma unroll
            for (int i = 0; i < 4; ++i) { x[k * 8 + 2 * i] = bflo(w[i]); x[k * 8 + 2 * i + 1] = bfhi(w[i]); } }
#pragma unroll
        for (int i = 0; i < 16; ++i) s += x[i];
#pragma unroll
        for (int m = 1; m < 64; m <<= 1) s += __shfl_xor(s, m);
        const float mean = s * (1.0f / 1024.0f); float q = 0.f;
#pragma unroll
        for (int i = 0; i < 16; ++i) { x[i] -= mean; q += x[i] * x[i]; }
#pragma unroll
        for (int m = 1; m < 64; m <<= 1) q += __shfl_xor(q, m);
        const float rstd = rsqrtf(q * (1.0f / 1024.0f) + 1e-5f);
#pragma unroll
        for (int k = 0; k < 2; ++k)
#pragma unroll
            for (int h2 = 0; h2 < 2; ++h2) { const int col = k * 512 + lane * 8 + h2 * 4;
                const f32x4 xv = {x[k * 8 + h2 * 4], x[k * 8 + h2 * 4 + 1], x[k * 8 + h2 * 4 + 2], x[k * 8 + h2 * 4 + 3]};
                *(f32x4*)(p.out + O_Y + (size_t)row * DM + col) = xv * rstd * *(const f32x4*)(g + col) + *(const f32x4*)(b + col); }
    }
}

constexpr int N_PHASES = 17;
__device__ __forceinline__ void grid_barrier(const Params& p, unsigned k) {
    asm volatile("s_waitcnt vmcnt(0)" ::: "memory");
    __syncthreads();
    if (p.wv == 0) {
        unsigned* bar = (unsigned*)(p.ws + WS_BAR);
        if (p.nloc == 0) {
            __builtin_amdgcn_fence(__ATOMIC_RELEASE, "agent");
            asm volatile("s_waitcnt vmcnt(0)" ::: "memory");
            const unsigned target = (k + 1u) * gridDim.x;
            if (__builtin_amdgcn_mbcnt_hi(~0u, __builtin_amdgcn_mbcnt_lo(~0u, 0u)) == 0u) {
                __hip_atomic_fetch_add(bar, 1u, __ATOMIC_RELAXED, __HIP_MEMORY_SCOPE_AGENT);
                while (__hip_atomic_load(bar, __ATOMIC_RELAXED, __HIP_MEMORY_SCOPE_AGENT) < target) __builtin_amdgcn_s_sleep(2);
            }
            __builtin_amdgcn_fence(__ATOMIC_ACQUIRE, "agent");
            asm volatile("s_waitcnt vmcnt(0)" ::: "memory");
        } else {
            const unsigned nloc = (unsigned)p.nloc, nx = (unsigned)p.nx, x = (unsigned)p.xcc;
            unsigned old = 0;
            if (__builtin_amdgcn_mbcnt_hi(~0u, __builtin_amdgcn_mbcnt_lo(~0u, 0u)) == 0u) old = __hip_atomic_fetch_add(bar + 128 + 16 * x, 1u, __ATOMIC_RELAXED, __HIP_MEMORY_SCOPE_AGENT);
            old = (unsigned)__builtin_amdgcn_readfirstlane((int)old);
            const unsigned gen = old / nloc;
            if (old + 1u == (gen + 1u) * nloc) {
                __builtin_amdgcn_fence(__ATOMIC_RELEASE, "agent");
                asm volatile("s_waitcnt vmcnt(0)" ::: "memory");
                unsigned og = 0;
                if (__builtin_amdgcn_mbcnt_hi(~0u, __builtin_amdgcn_mbcnt_lo(~0u, 0u)) == 0u) og = __hip_atomic_fetch_add(bar + 384, 1u, __ATOMIC_RELAXED, __HIP_MEMORY_SCOPE_AGENT);
                og = (unsigned)__builtin_amdgcn_readfirstlane((int)og);
                const unsigned tg = og / nx;
                if (og + 1u == (tg + 1u) * nx) { if (__builtin_amdgcn_mbcnt_hi(~0u, __builtin_amdgcn_mbcnt_lo(~0u, 0u)) == 0u) __hip_atomic_fetch_add(bar + 400, 1u, __ATOMIC_RELAXED, __HIP_MEMORY_SCOPE_AGENT); }
                else { while (__hip_atomic_load(bar + 400, __ATOMIC_RELAXED, __HIP_MEMORY_SCOPE_AGENT) == tg) __builtin_amdgcn_s_sleep(1); }
                __builtin_amdgcn_fence(__ATOMIC_ACQUIRE, "agent");
                if (__builtin_amdgcn_mbcnt_hi(~0u, __builtin_amdgcn_mbcnt_lo(~0u, 0u)) == 0u) __hip_atomic_fetch_add(bar + 256 + 16 * x, 1u, __ATOMIC_RELAXED, __HIP_MEMORY_SCOPE_AGENT);
                asm volatile("s_waitcnt vmcnt(0)" ::: "memory");
            } else {
                while (__hip_atomic_load(bar + 256 + 16 * x, __ATOMIC_RELAXED, __HIP_MEMORY_SCOPE_AGENT) == gen) __builtin_amdgcn_s_sleep(1);
                __builtin_amdgcn_fence(__ATOMIC_ACQUIRE, "agent");
                asm volatile("s_waitcnt vmcnt(0)" ::: "memory");
            }
        }
    }
    __syncthreads();
}
#define ST(i) ((float*)(ws + WS_STATS) + (size_t)(i) * (SZ_STATS / 4))
__device__ __forceinline__ EpiOut make_epi_ffn_out(const Params& p, int ph) {
    unsigned char* ws = p.ws;
    const int stp = ph == 8 ? 1 : ph == 10 ? 2 : 4, stn = ph == 2 ? 0 : ph == 8 ? 2 : ph == 10 ? 3 : 5;
    const int lni = ph == 8 ? 1 : ph == 10 ? 2 : 4;
    return EpiOut{(float*)(ws + WS_PRE), (bf16_t*)(ws + WS_XB16), ST(stp), ST(stn), p.ln_g + lni * DM, p.ln_b + lni * DM, p.x_prompt, p.x_sample, 0.5f, ph == 2};
}
__device__ __forceinline__ size_t ffn_out_w(int ph) { return ph == 2 ? WS_WF1OUT0 : ph == 8 ? WS_WF2OUT0 : ph == 10 ? WS_WF1OUT1 : WS_WF2OUT1; }
__device__ __forceinline__ void run_ffn_in(const Params& p, LAS unsigned char* lds, int ph) {
    unsigned char* ws = p.ws;
    const int layer = ph >= 9, second = (ph == 7 || ph == 14);
    const size_t wo = layer == 0 ? (second ? WS_WF2IN0 : WS_WF1IN0) : (second ? WS_WF2IN1 : WS_WF1IN1);
    const size_t co = ph == 7 ? WS_C_F2IN0 : ph == 9 ? WS_C_F1IN1 : WS_C_F2IN1;
    const int sti = ph == 7 ? 1 : ph == 9 ? 2 : 4;
    const bool special = gridDim.x == 256;
    unsigned* ctr = (unsigned*)(ws + WS_BAR) + 16 * (1 + (ph == 1 ? 0 : ph == 7 ? 1 : ph == 9 ? 2 : 3));
    Sched S; S.c = p.vb; S.init(ws + WS_XB16, ws + wo, MT, NFF, DM, 0); if (special) S.mode = 1;
    EpiFfnIn E{(bf16_t*)(ws + WS_ACT + A_H), ST(sti), (const float*)(ws + co), (const float*)(ws + co) + NFF, ph != 1};
    gemm_phase<false>(lds, S, E, p.wv, special ? ctr : nullptr);
    if (special && ph == 1 && p.vb >= 188 && p.vb < 248) phase_prep(p, lds, 3, p.vb - 188, 60);
    if (special && p.vb >= 248) {
        if (p.wv == 0) { while (__hip_atomic_load(ctr, __ATOMIC_RELAXED, __HIP_MEMORY_SCOPE_AGENT) < 44u * 8u) __builtin_amdgcn_s_sleep(8); }
        __syncthreads();
        __builtin_amdgcn_fence(__ATOMIC_ACQUIRE, "agent");
        asm volatile("s_waitcnt vmcnt(0)" ::: "memory");
        const int su = p.vb - 248;
        Sched S2; S2.c = p.vb; S2.init(ws + WS_ACT + A_H, ws + ffn_out_w(ph + 1), MT, DM, DFF, 0); S2.mode = 2; S2.upm = 64 + (su >> 2); S2.upn = su & 3;
        const EpiOut E2 = make_epi_ffn_out(p, ph + 1);
        gemm_phase<false>(lds, S2, E2, p.wv);
    }
}
__device__ __forceinline__ void run_ffn_out(const Params& p, LAS unsigned char* lds, int ph) {
    unsigned char* ws = p.ws;
    const bool special = gridDim.x == 256;
    Sched S; S.c = p.vb; S.init(ws + WS_ACT + A_H, ws + ffn_out_w(ph), special ? MP : MT, DM, DFF, 0);
    const EpiOut E = make_epi_ffn_out(p, ph);
    gemm_phase<false>(lds, S, E, p.wv);
}
__device__ __forceinline__ void run_mix_out(const Params& p, LAS unsigned char* lds, int ph, int M_rows, int only_sample_unit, int khalf = -1) {
    unsigned char* ws = p.ws;
    const bool ret = ph == 6;
    Sched S; S.c = p.vb; S.init(ws + WS_ACT + (ret ? A_OG : A_HG), ws + (ret ? WS_WRETOUT : WS_WRECOUT), M_rows, DM, ret ? RV : DRNN, 0);
    if (only_sample_unit >= 0) { S.mode = 2; S.upm = 64 + (only_sample_unit >> 2); S.upn = only_sample_unit & 3; }
    const int lni = ret ? 0 : 3;
    EpiOut E{(float*)(ws + WS_PRE), (bf16_t*)(ws + WS_XB16), ST(lni), ST(lni + 1), p.ln_g + lni * DM, p.ln_b + lni * DM, p.x_prompt, p.x_sample, 1.0f, 0};
    if (khalf >= 0) {
        S.ntl = S.ntl / 2; S.koff = (size_t)khalf * S.ntl * BK * 2;
        float* part = (float*)(ws + WS_PRE) + (size_t)only_sample_unit * 65536; unsigned* pflag = (unsigned*)(ws + WS_BAR) + 113 + only_sample_unit;
        if (khalf == 1) { EpiPart EP{part, pflag}; gemm_phase<false>(lds, S, EP, p.wv); return; }
        EpiOutT<true> ES{E.pre, E.xb, E.st_prev, E.st_new, E.g, E.b, E.xp, E.xs, E.scale, E.raw};
        gemm_phase<false>(lds, S, ES, p.wv); return;
    }
    gemm_phase<false>(lds, S, E, p.wv);
}

__global__ void __launch_bounds__(NTHR) fwd_megakernel(Params p_) {
    Params p = p_; p.wv = __builtin_amdgcn_readfirstlane((int)(threadIdx.x >> 6));
    extern __shared__ __attribute__((aligned(16))) unsigned char lds_raw[];
    LAS unsigned char* lds = (LAS unsigned char*)lds_raw;
    const int lo = (int)p.ph_lo, hi = (int)p.ph_hi;
    p.vb = (int)blockIdx.x; p.xcc = 0; p.nloc = 0; p.nx = 0;
    if (hi - lo > 1) {
        unsigned* cen = (unsigned*)(p.ws + WS_BAR) + 96;
        const unsigned xcc = (unsigned)__builtin_amdgcn_s_getreg((3 << 11) | 20) & 0xFu;
        unsigned rank = 0;
        if (threadIdx.x == 0) rank = __hip_atomic_fetch_add(cen + (xcc & 7u), 1u, __ATOMIC_RELAXED, __HIP_MEMORY_SCOPE_AGENT);
        rank = (unsigned)__builtin_amdgcn_readfirstlane((int)rank);
        cg::this_grid().sync();
        bool ok = gridDim.x == 256 && xcc < 8u;
#pragma unroll
        for (int j = 0; j < 8; ++j) ok = ok && (__hip_atomic_load(cen + j, __ATOMIC_RELAXED, __HIP_MEMORY_SCOPE_AGENT) == 32u);
        LAS unsigned* sh = (LAS unsigned*)lds;
        if (threadIdx.x == 0) sh[0] = rank;
        __syncthreads();
        const unsigned r0 = sh[0];
        __syncthreads();
        if (ok) { p.vb = __builtin_amdgcn_readfirstlane((int)(r0 * 8u + xcc)); p.xcc = (int)xcc; p.nloc = 32; p.nx = 8; }
    }
    unsigned bk = 0;
#define PHASE(ph, ...) if (lo <= (ph) && (ph) < hi) { __VA_ARGS__; if ((ph) + 1 < hi) grid_barrier(p, bk++); }
    PHASE(0, phase_prep(p, lds, gridDim.x == 256 ? 1 : 0, p.vb, (int)gridDim.x))
    PHASE(1, run_ffn_in(p, lds, 1))
    PHASE(2, run_ffn_out(p, lds, 2))
    PHASE(3, { unsigned char* ws = p.ws; const bool special = gridDim.x == 256; unsigned* ctr = (unsigned*)(ws + WS_BAR) + 80;
               Sched S; S.c = p.vb; S.init(ws + WS_XB16, ws + WS_WRETIN, MT, NRET, DM, 0); if (special) S.mode = 3; EpiRetIn E{ws};
               if (!special) gemm_phase<true>(lds, S, E, p.wv, nullptr);
               else {
                   const int rb = 1 + (p.vb % 6);
                   S.iend = rb; gemm_phase<true>(lds, S, E, p.wv, ctr);
                   if (p.wv == 0) { while (__hip_atomic_load(ctr, __ATOMIC_RELAXED, __HIP_MEMORY_SCOPE_AGENT) < 48u * 8u) __builtin_amdgcn_s_sleep(8);
                                    __builtin_amdgcn_fence(__ATOMIC_ACQUIRE, "agent"); asm volatile("s_waitcnt vmcnt(0)" ::: "memory"); }
                   __syncthreads();
                   for (int su = p.vb; su < 512; su += 256) ret_sample_unit<8>(p, su, lds);
                   S.ibase = rb; S.iend = 1 << 20; gemm_phase<true>(lds, S, E, p.wv, ctr);
                   if (p.vb >= 48) phase_prep(p, lds, 2, p.vb - 48, 208);
               } })
    PHASE(4, { const int nu = gridDim.x == 256 ? 256 : 768; for (int u = p.vb; u < nu; u += gridDim.x) { if (u < 256) ret_prompt_unit(p, u, lds); else ret_sample_unit<4>(p, u - 256, lds); } })
    PHASE(5, { if (gridDim.x == 256 && p.vb >= 240) run_mix_out(p, lds, 6, MT, (p.vb - 240) >> 1, (p.vb - 240) & 1); else phase_gn(p); })
    PHASE(6, run_mix_out(p, lds, 6, gridDim.x == 256 ? MP : MT, -1))
    PHASE(7, run_ffn_in(p, lds, 7))
    PHASE(8, run_ffn_out(p, lds, 8))
    PHASE(9, run_ffn_in(p, lds, 9))
    PHASE(10, run_ffn_out(p, lds, 10))
    PHASE(11, { unsigned char* ws = p.ws; const bool special = gridDim.x == 256; unsigned* ctr = (unsigned*)(ws + WS_BAR) + 112;
                Sched S; S.c = p.vb; S.init(ws + WS_XB16, ws + WS_WRECIN, MT, NREC, DM, 0); if (special) S.mode = 4;
                EpiRecIn E{(bf16_t*)(ws + WS_ACT + A_GATE), (float*)(ws + WS_ACT + A_XBR), p.out, ST(3), (const float*)(ws + WS_C_RECIN), (const float*)(ws + WS_C_RECIN) + NREC};
                gemm_phase<false>(lds, S, E, p.wv, special ? ctr : nullptr);
                if (special && p.vb >= 224) {
                    if (p.wv == 0) { while (__hip_atomic_load(ctr, __ATOMIC_RELAXED, __HIP_MEMORY_SCOPE_AGENT) < 20u * 8u) __builtin_amdgcn_s_sleep(8);
                                     __builtin_amdgcn_fence(__ATOMIC_ACQUIRE, "agent"); asm volatile("s_waitcnt vmcnt(0)" ::: "memory"); }
                    __syncthreads();
                    rglru_unit(p, 1024 + (p.vb - 224), lds);
                } })
    PHASE(12, { if (gridDim.x != 256) { for (int u = p.vb; u < 1056; u += gridDim.x) rglru_unit(p, u, lds); }
                else if (p.vb >= 248) { run_mix_out(p, lds, 13, MT, p.vb - 248); rglru_unit(p, p.vb + 512, lds); rglru_unit(p, p.vb + 768, lds); }
                else {
                    for (int sl = 0; sl < 5; ++sl) {
                        int u;
                        if (p.vb < 8) u = sl == 0 ? 248 + p.vb : p.vb + 256 * (sl - 1);
                        else if (p.vb < 16) u = sl == 0 ? p.vb : (sl == 1 ? 248 + (p.vb - 8) + 256 : p.vb + 256 * (sl - 1));
                        else u = sl < 4 ? p.vb + 256 * sl : -1;
                        if (u >= 0) rglru_unit(p, u, lds);
                    }
                } })
    PHASE(13, run_mix_out(p, lds, 13, gridDim.x == 256 ? MP : MT, -1))
    PHASE(14, run_ffn_in(p, lds, 14))
    PHASE(15, run_ffn_out(p, lds, 15))
    PHASE(16, phase_final_ln(p))
#undef PHASE
}
#undef ST

extern "C" void kernel_launch(void* const* d_in, const int* in_sizes, int n_in, void* d_out, int out_size, void* d_ws, size_t ws_size, hipStream_t stream) {
    static int grid = 0;
    if (grid == 0) {
        if (n_in != 23 || ws_size < WS_END) { fprintf(stderr, "kernel_launch: unexpected n_in %d or ws_size %zu (< %zu)\n", n_in, ws_size, (size_t)WS_END); grid = -1; return; }
        int dev = 0, cus = 0, per_cu = 0;
        hipGetDevice(&dev);
        hipDeviceGetAttribute(&cus, hipDeviceAttributeMultiprocessorCount, dev);
        if (hipFuncSetAttribute((const void*)fwd_megakernel, hipFuncAttributeMaxDynamicSharedMemorySize, LDS_BYTES) != hipSuccess) { fprintf(stderr, "kernel_launch: hipFuncSetAttribute failed\n"); grid = -1; return; }
        if (hipOccupancyMaxActiveBlocksPerMultiprocessor(&per_cu, (const void*)fwd_megakernel, NTHR, LDS_BYTES) != hipSuccess || per_cu < 1) { fprintf(stderr, "kernel_launch: occupancy query failed (%d)\n", per_cu); per_cu = 1; }
        (void)hipGetLastError();
        grid = cus * per_cu;
    }
    if (grid < 0) return;
    Params p{};
    const float** pp = (const float**)&p;
    for (int i = 0; i < 23; ++i) pp[i] = (const float*)d_in[i];
    p.out = (float*)d_out; p.ws = (unsigned char*)d_ws;
#if PER_PHASE_LAUNCH
    for (int ph = 0; ph < N_PHASES; ++ph) { p.ph_lo = ph; p.ph_hi = ph + 1; hipLaunchKernelGGL(fwd_megakernel, dim3(grid), dim3(NTHR), LDS_BYTES, stream, p); }
#else
    p.ph_lo = 0; p.ph_hi = N_PHASES;
    if (hipMemsetAsync((char*)d_ws + WS_BAR, 0, 2048, stream) != hipSuccess) { fprintf(stderr, "kernel_launch: memset of the barrier word failed\n"); return; }
    void* args[] = {&p};
    hipError_t e = hipLaunchCooperativeKernel((const void*)fwd_megakernel, dim3(grid), dim3(NTHR), args, LDS_BYTES, stream);
    if (e != hipSuccess) fprintf(stderr, "cooperative launch failed: %s (grid %d)\n", hipGetErrorString(e), grid);
#endif
}
```

```cpp
#include <hip/hip_runtime.h>
#include <hip/hip_cooperative_groups.h>
#include <cstdio>
namespace cg = cooperative_groups;

#ifndef PER_PHASE_LAUNCH
#define PER_PHASE_LAUNCH 0
#endif

#define LAS __attribute__((address_space(3)))
typedef unsigned short bf16_t;
typedef short bf16x8 __attribute__((ext_vector_type(8)));
typedef float f32x4 __attribute__((ext_vector_type(4)));
typedef float f32x2 __attribute__((ext_vector_type(2)));
typedef unsigned u32x2 __attribute__((ext_vector_type(2)));
typedef unsigned u32x4 __attribute__((ext_vector_type(4)));

constexpr int DM = 1024, MP = 16384, MS = 512, MT = 16896, DFF = 2816, NFF = 5632, RV = 2048, NRET = 6144, DRNN = 1280, NREC = 2560;
constexpr float ALPHA = 1.41421356237309515f;
constexpr int NTHR = 512;
constexpr int LDS_BYTES = 161792;

constexpr size_t O_Y = 0, O_RETP = 17301504, O_CONVP = 21495808, O_LRUP = 21526528, O_RETS = 21536768, O_CONVS = 88645632, O_LRUS = 89137152;

constexpr size_t al256(size_t x) { return (x + 255) & ~(size_t)255; }
constexpr size_t SZ_WFIN = (size_t)NFF * DM * 2, SZ_WFOUT = (size_t)DM * DFF * 2;
constexpr size_t WS_WF1IN0 = 0, WS_WF1IN1 = WS_WF1IN0 + SZ_WFIN, WS_WF2IN0 = WS_WF1IN1 + SZ_WFIN, WS_WF2IN1 = WS_WF2IN0 + SZ_WFIN;
constexpr size_t WS_WF1OUT0 = WS_WF2IN1 + SZ_WFIN, WS_WF1OUT1 = WS_WF1OUT0 + SZ_WFOUT, WS_WF2OUT0 = WS_WF1OUT1 + SZ_WFOUT, WS_WF2OUT1 = WS_WF2OUT0 + SZ_WFOUT;
constexpr size_t WS_WRETIN = WS_WF2OUT1 + SZ_WFOUT, WS_WRETOUT = WS_WRETIN + (size_t)NRET * DM * 2, WS_WRECIN = WS_WRETOUT + (size_t)DM * RV * 2;
constexpr size_t WS_WRECOUT = WS_WRECIN + (size_t)NREC * DM * 2, WS_WA = WS_WRECOUT + (size_t)DM * DRNN * 2, WS_WI = WS_WA + al256(8 * 160 * 160 * 2);
constexpr size_t WS_C_F1IN1 = WS_WI + al256(8 * 160 * 160 * 2);
constexpr size_t WS_C_F2IN0 = WS_C_F1IN1 + 2 * NFF * 4, WS_C_F2IN1 = WS_C_F2IN0 + 2 * NFF * 4, WS_C_RETIN = WS_C_F2IN1 + 2 * NFF * 4;
constexpr size_t WS_C_RECIN = WS_C_RETIN + 2 * NRET * 4;
constexpr size_t WS_COS = WS_C_RECIN + 2 * NREC * 4, WS_SIN = WS_COS + 2052 * 128 * 4, WS_COST = WS_SIN + 2052 * 128 * 4, WS_SINT = WS_COST + 128 * 2048 * 4;
constexpr size_t WS_FLAGS = WS_SINT + 128 * 2048 * 4;
constexpr size_t WS_CARRY = WS_FLAGS + 64 * 16 * 64;
constexpr size_t WS_SPL = WS_CARRY + 64 * 16 * 160 * 4;
constexpr size_t WS_BAR = WS_SPL + al256(DRNN * 4);
constexpr size_t WS_STATS = WS_BAR + 2048;
constexpr size_t SZ_STATS = (size_t)MT * 32 * 4;
constexpr size_t WS_XB16 = WS_STATS + 6 * SZ_STATS;
constexpr size_t WS_PRE = WS_XB16 + (size_t)MT * DM * 2;
constexpr size_t WS_ACT = WS_PRE + (size_t)MT * DM * 4;
constexpr size_t A_H = 0;
constexpr size_t A_Q = 0, A_K = A_Q + (size_t)MT * 1024 * 2, A_KT = A_K + (size_t)MT * 1024 * 2, A_VT = A_KT + (size_t)1024 * MP * 2;
constexpr size_t A_VS = A_VT + (size_t)2048 * MP * 2, A_SG = A_VS + (size_t)MS * 2048 * 2, A_O = A_SG + (size_t)MT * 2048 * 2, A_OG = A_O + (size_t)MP * 2048 * 2;
constexpr size_t A_END_RET = A_OG + (size_t)MT * 2048 * 2;
constexpr size_t A_GATE = 0, A_XBR = A_GATE + (size_t)MT * DRNN * 2, A_HG = A_XBR + (size_t)MT * DRNN * 4;
constexpr size_t WS_END = WS_ACT + A_END_RET;

struct Params {
    const float* x_prompt; const float* x_sample; const float* state_ret; const float* state_conv; const float* state_lru;
    const float* ln_g; const float* ln_b; const float* ffn1_w_in; const float* ffn1_w_out; const float* ffn2_w_in; const float* ffn2_w_out;
    const float* ret_w_in; const float* ret_gn_g; const float* ret_w_out; const float* rec_w_in; const float* rec_conv_w; const float* rec_conv_b;
    const float* rec_w_a; const float* rec_b_a; const float* rec_w_i; const float* rec_b_i; const float* rec_lam; const float* rec_w_out;
    float* out; unsigned char* ws; int ph_lo, ph_hi, wv, vb, xcc, nloc, nx, pad;
};

#define otid() otid_(p.wv)
__device__ __forceinline__ int otid_(int wv) { int t = wv * 64 + (int)__builtin_amdgcn_mbcnt_hi(~0u, __builtin_amdgcn_mbcnt_lo(~0u, 0u)); asm volatile("" : "+v"(t)); return t; }
__device__ __forceinline__ unsigned pk_bf16(float lo, float hi) { unsigned r; asm("v_cvt_pk_bf16_f32 %0, %1, %2" : "=v"(r) : "v"(lo), "v"(hi)); return r; }
__device__ __forceinline__ float bf2f(bf16_t b) { return __uint_as_float(((unsigned)b) << 16); }
__device__ __forceinline__ float bflo(unsigned w) { return __uint_as_float(w << 16); }
__device__ __forceinline__ float bfhi(unsigned w) { return __uint_as_float(w & 0xffff0000u); }
__device__ __forceinline__ float sigmoid_(float x) { return __builtin_amdgcn_rcpf(1.0f + __expf(-x)); }
__device__ __forceinline__ float silu_(float x) { return x * sigmoid_(x); }
__device__ __forceinline__ float gelu_tanh_(float x) { return x * sigmoid_(1.5957691216057308f * (x + 0.044715f * x * x * x)); }
__device__ __forceinline__ float one_minus_exp(float x) {
    const float ps = x * (1.f + x * (0.5f + x * (1.f / 6.f + x * (1.f / 24.f + x * (1.f / 120.f + x * (1.f / 720.f + x * (1.f / 5040.f)))))));
    const float e = 1.f - __expf(x);
    return x > -0.5f ? -ps : e;
}
__device__ __forceinline__ f32x4 mfma16(bf16x8 a, bf16x8 b, f32x4 c) { return __builtin_amdgcn_mfma_f32_16x16x32_bf16(a, b, c, 0, 0, 0); }

constexpr int BM = 256, BK = 64, HALF = 128, HTB = HALF * BK * 2, NXCD = 8, WGM = 8;
__device__ __forceinline__ int lds_byte(int r, int c) { const int st = (r >> 4) * 2 + (c >> 5), rr = r & 15, cc = c & 31, ob = rr * 64 + cc * 2; return st * 1024 + (ob ^ (((ob >> 9) & 1) << 5)); }
__device__ __forceinline__ void stage_rc(int b, int& R, int& C) { const int st = b / 1024, sb = b % 1024, swz = sb ^ (((sb >> 9) & 1) << 5); R = (st >> 1) * 16 + swz / 64; C = (st & 1) * 32 + (swz % 64) / 2; }

struct Unit { int pm, pn; };
struct Sched {
    const char* A; const char* B; int nM, nN, nwg, nExtra, K, G, c, mode, upm, upn, ntl, ibase, iend;
    __device__ __forceinline__ void init(const void* A_, const void* B_, int M, int N, int K_, int extra) {
        A = (const char*)A_; B = (const char*)B_; nM = M / BM; nN = N / BM; nwg = nM * nN; nExtra = extra; K = K_; G = gridDim.x; mode = 0; upm = 0; upn = 0; ntl = K_ / BK; ibase = 0; iend = 1 << 20; }
    __device__ __forceinline__ void std_map(int wgid, int nwg_, int nM_, Unit& u) const {
        { const int q = nwg_ / NXCD, r = nwg_ % NXCD, xcd = wgid % NXCD, off = wgid / NXCD; wgid = (xcd < r ? xcd * (q + 1) : r * (q + 1) + (xcd - r) * q) + off; }
        const int nig = WGM * nN, gid = wgid / nig, fm = gid * WGM, gsz = (nM_ - fm) < WGM ? (nM_ - fm) : WGM;
        u.pm = fm + ((wgid % nig) % gsz); u.pn = (wgid % nig) / gsz;
    }
    __device__ __forceinline__ bool next(int i, Unit& u) const {
        i += ibase; if (i >= iend) return false;
        if (mode == 2) { u.pm = upm; u.pn = upn; return i == 0; }
        if (mode == 1) {
            int L;
            if (c >= 248) { if (i >= 3) return false; L = i * 256 + c; }
            else if (i < 5) L = i * 256 + c;
            else if (i == 5) { if (c < 172) L = 1280 + c; else if (c < 188) L = (3 + ((c - 172) & 1)) * 256 + 248 + ((c - 172) >> 1); else return false; }
            else return false;
            if (L < 44) { u.pm = 64 + L / 22; u.pn = L % 22; return true; }
            std_map(L - 44, 1408, 64, u); return true;
        }
        if (mode == 4) {
            const int L4 = i * 256 + c; if (L4 >= 660) return false;
            if (L4 < 20) { u.pm = 64 + L4 / 10; u.pn = L4 % 10; return true; }
            std_map(L4 - 20, 640, 64, u); return true;
        }
        if (mode == 3) {
            const int L3 = i * 256 + c; if (L3 >= 1584) return false;
            if (L3 < 48) { u.pm = 64 + L3 / 24; u.pn = L3 % 24; return true; }
            std_map(L3 - 48, 1536, 64, u); return true;
        }
        const long L = (long)i * G + c; if (L >= nwg + nExtra) return false;
        if (L >= nwg) { const int e = (int)L - nwg; u.pm = e & 63; u.pn = 24 + (e >> 6); return true; }
        std_map((int)L, nwg, nM, u); return true;
    }
};
__device__ __forceinline__ bool unit_swapped(const Unit& u) { return (u.pn >= 24) || (u.pn >= 8 && u.pn < 16 && u.pm < 64); }

template <bool SWAP, class Epi>
__device__ __forceinline__ void gemm_phase(LAS unsigned char* lds, const Sched& S, const Epi& E, const int wv_, unsigned* done_ctr = nullptr) {
    const int tid = otid_(wv_), wid = __builtin_amdgcn_readfirstlane(tid >> 6), lane = tid & 63, wr = wid >> 2, wc = wid & 3, fr = lane & 15, fq = lane >> 4;
    const int K = S.K, nt = S.ntl;
    unsigned voff[2];
#pragma unroll
    for (int i = 0; i < 2; ++i) { int R, C; stage_rc(tid * 16 + i * 8192, R, C); voff[i] = (unsigned)(R * K + C) * 2u; }
    const size_t kstep = (size_t)(BK * 2);
    const size_t hstep = (size_t)HALF * K * 2;
    const size_t tstep = 2 * hstep;
    const unsigned ldsw = (unsigned)wid * 1024u;
    const int aoff = lds_byte(wr * 64 + fr, fq * 8), boff = lds_byte(wc * 32 + fr, fq * 8);
#define G_SA(b, h) (((b) * 2 + (h)) * HTB)
#define G_SB(b, h) ((4 + (b) * 2 + (h)) * HTB)
#define G_STAGE(bufoff, gbase) do { _Pragma("unroll") for (int _i = 0; _i < 2; ++_i) \
        __builtin_amdgcn_global_load_lds((const unsigned*)((const char*)(gbase) + voff[_i]), (LAS unsigned*)(lds + (bufoff) + ldsw + _i * 8192), 16, 0, 0); } while (0)
#define G_LDA(dst, b, h) do { _Pragma("unroll") for (int m = 0; m < 4; ++m) _Pragma("unroll") for (int k = 0; k < 2; ++k) dst[m][k] = *(const LAS bf16x8*)(lds + G_SA(b, h) + aoff + m * 2048 + k * 1024); } while (0)
#define G_LDB(dst, b, h) do { _Pragma("unroll") for (int n = 0; n < 2; ++n) _Pragma("unroll") for (int k = 0; k < 2; ++k) dst[n][k] = *(const LAS bf16x8*)(lds + G_SB(b, h) + boff + n * 2048 + k * 1024); } while (0)
#define G_MMA(ai, bj, At, Bt) do { __builtin_amdgcn_s_setprio(1); _Pragma("unroll") for (int m = 0; m < 4; ++m) _Pragma("unroll") for (int n = 0; n < 2; ++n) _Pragma("unroll") for (int k = 0; k < 2; ++k) \
        acc[ai][bj][m][n] = __builtin_amdgcn_mfma_f32_16x16x32_bf16(Bt[n][k], At[m][k], acc[ai][bj][m][n], 0, 0, 0); __builtin_amdgcn_s_setprio(0); } while (0)
#define G_WAIT_V(n) asm volatile("s_waitcnt vmcnt(" #n ")" ::: "memory")
#define G_WAIT_L(n) asm volatile("s_waitcnt lgkmcnt(" #n ")" ::: "memory")
#define G_BAR __builtin_amdgcn_s_barrier()
#define G_SCHED __builtin_amdgcn_sched_barrier(0)
#define G_PTRS(u, pa, pb) do { if (SWAP && unit_swapped(u)) { const int wpn = (u).pn >= 24 ? (u).pn - 20 : (u).pn; pa = S.B + (size_t)wpn * tstep; pb = S.A + (size_t)(u).pm * tstep; } \
        else { pa = S.A + (size_t)(u).pm * tstep; pb = S.B + (size_t)(u).pn * tstep; } } while (0)
    Unit cur, nxt; int ui = 0;
    if (!S.next(0, cur)) return;
    f32x4 acc[2][2][4][2];
#pragma unroll
    for (int a = 0; a < 2; ++a)
#pragma unroll
        for (int b = 0; b < 2; ++b)
#pragma unroll
            for (int m = 0; m < 4; ++m)
#pragma unroll
                for (int n = 0; n < 2; ++n) acc[a][b][m][n] = (f32x4){0.f, 0.f, 0.f, 0.f};
    bf16x8 At[4][2], B0[2][2], B1[2][2];
    const char* cA; const char* cB; G_PTRS(cur, cA, cB);
    G_STAGE(G_SB(0, 0), cB); G_STAGE(G_SA(0, 0), cA); G_STAGE(G_SB(0, 1), cB + hstep); G_STAGE(G_SA(0, 1), cA + hstep);
    if (wr == 1) G_BAR;
    G_WAIT_V(4); G_BAR;
    G_STAGE(G_SB(1, 0), cB + kstep); G_STAGE(G_SA(1, 0), cA + kstep); G_STAGE(G_SB(1, 1), cB + hstep + kstep);
    G_WAIT_V(6); G_BAR;
    for (;;) {
        const bool has_next = S.next(ui + 1, nxt);
        const char* nA = cA; const char* nB = cB;
        if (has_next) G_PTRS(nxt, nA, nB);
        for (int t = 0; t < nt; t += 2) {
            const bool last = (t == nt - 2);
            const char* a1 = cA + (size_t)(t + 1) * kstep;
            const char* a2 = last ? nA : cA + (size_t)(t + 2) * kstep; const char* b2 = last ? nB : cB + (size_t)(t + 2) * kstep;
            const char* a3 = a2 + kstep; const char* b3 = b2 + kstep;
            G_LDB(B0, 0, 0); G_SCHED; G_LDA(At, 0, 0); G_STAGE(G_SA(1, 1), a1 + hstep);
            G_WAIT_L(8); G_BAR; G_WAIT_L(0); G_MMA(0, 0, At, B0); G_BAR; G_SCHED;
            G_LDB(B1, 0, 1); G_STAGE(G_SB(0, 0), b2);
            G_BAR; G_WAIT_L(0); G_MMA(0, 1, At, B1); G_BAR;
            G_LDA(At, 0, 1); G_STAGE(G_SA(0, 0), a2);
            G_BAR; G_WAIT_L(0); G_MMA(1, 0, At, B0); G_BAR; G_SCHED;
            G_STAGE(G_SB(0, 1), b2 + hstep);
            G_WAIT_V(6); G_BAR; G_MMA(1, 1, At, B1); G_BAR;
            G_LDB(B0, 1, 0); G_SCHED; G_LDA(At, 1, 0); G_STAGE(G_SA(0, 1), a2 + hstep);
            G_WAIT_L(8); G_BAR; G_WAIT_L(0); G_MMA(0, 0, At, B0); G_BAR; G_SCHED;
            G_LDB(B1, 1, 1); G_STAGE(G_SB(1, 0), b3);
            G_BAR; G_WAIT_L(0); G_MMA(0, 1, At, B1); G_BAR;
            G_LDA(At, 1, 1); G_STAGE(G_SA(1, 0), a3);
            G_BAR; G_WAIT_L(0); G_MMA(1, 0, At, B0); G_BAR; G_SCHED;
            G_STAGE(G_SB(1, 1), b3 + hstep);
            G_WAIT_V(6); G_BAR; G_MMA(1, 1, At, B1); G_BAR;
        }
        E(acc, cur, wr, wc, fr, fq);
        if (done_ctr && cur.pm >= 64) {
            __builtin_amdgcn_fence(__ATOMIC_RELEASE, "agent");
            asm volatile("s_waitcnt vmcnt(0)" ::: "memory");
            if (lane == 0) __hip_atomic_fetch_add(done_ctr, 1u, __ATOMIC_RELAXED, __HIP_MEMORY_SCOPE_AGENT);
        }
        if (!has_next) break;
#pragma unroll
        for (int a = 0; a < 2; ++a)
#pragma unroll
            for (int b = 0; b < 2; ++b)
#pragma unroll
                for (int m = 0; m < 4; ++m)
#pragma unroll
                    for (int n = 0; n < 2; ++n) acc[a][b][m][n] = (f32x4){0.f, 0.f, 0.f, 0.f};
        cur = nxt; cA = nA; cB = nB; ++ui;
    }
    G_WAIT_V(0);
    if (wr == 0) G_BAR;
    G_BAR;
#undef G_SA
#undef G_SB
#undef G_STAGE
#undef G_LDA
#undef G_LDB
#undef G_MMA
#undef G_WAIT_V
#undef G_WAIT_L
#undef G_BAR
#undef G_SCHED
#undef G_PTRS
}

__device__ __forceinline__ void ln_rows(const float* st, int row0, int fq, float (&mu)[2][4], float (&rs)[2][4]) {
#pragma unroll
    for (int ai = 0; ai < 2; ++ai)
#pragma unroll
        for (int m = 0; m < 4; ++m) {
            const float* p = st + (unsigned)((row0 + ai * HALF + m * 16) * 32 + fq * 8);
            const f32x4 a = *(const f32x4*)p, b = *(const f32x4*)(p + 4);
            float s = (a[0] + a[2]) + (b[0] + b[2]), q = (a[1] + a[3]) + (b[1] + b[3]);
            s += __shfl_xor(s, 16); q += __shfl_xor(q, 16); s += __shfl_xor(s, 32); q += __shfl_xor(q, 32);
            const float mean = s * (1.0f / 1024.0f), var = q * (1.0f / 1024.0f) - mean * mean;
            mu[ai][m] = mean; rs[ai][m] = rsqrtf(var + 1e-5f);
            if (m == 3) asm volatile("" ::: "memory");
        }
}
__device__ __forceinline__ void ln_rows4(const float* st, int row0, int fq, float (&mu)[4], float (&rs)[4]) {
#pragma unroll
    for (int m = 0; m < 4; ++m) {
        const float* p = st + (unsigned)((row0 + m * 16) * 32 + fq * 8);
        const f32x4 a = *(const f32x4*)p, b = *(const f32x4*)(p + 4);
        float s = (a[0] + a[2]) + (b[0] + b[2]), q = (a[1] + a[3]) + (b[1] + b[3]);
        s += __shfl_xor(s, 16); q += __shfl_xor(q, 16); s += __shfl_xor(s, 32); q += __shfl_xor(q, 32);
        const float mean = s * (1.0f / 1024.0f), var = q * (1.0f / 1024.0f) - mean * mean;
        mu[m] = mean; rs[m] = rsqrtf(var + 1e-5f);
    }
    asm volatile("" ::: "memory");
}
__device__ __forceinline__ void ln_tok4(const float* st, int tok0, int fr, float (&mu)[4], float (&rs)[4]) {
#pragma unroll
    for (int i = 0; i < 4; ++i) {
        const f32x2 v = *(const f32x2*)(st + (unsigned)((tok0 + i) * 32 + fr * 2));
        float s = v[0], q = v[1];
        s += __shfl_xor(s, 1); q += __shfl_xor(q, 1); s += __shfl_xor(s, 2); q += __shfl_xor(q, 2);
        s += __shfl_xor(s, 4); q += __shfl_xor(q, 4); s += __shfl_xor(s, 8); q += __shfl_xor(q, 8);
        const float mean = s * (1.0f / 1024.0f), var = q * (1.0f / 1024.0f) - mean * mean;
        mu[i] = mean; rs[i] = rsqrtf(var + 1e-5f);
    }
}

struct EpiFfnIn {
    bf16_t* h; const float* st; const float* c1; const float* c2; int ln;
    __device__ __forceinline__ void operator()(const f32x4 (&acc)[2][2][4][2], const Unit& u, int wr, int wc, int fr_, int fq_) const {
        int fr = fr_, fq = fq_; asm volatile("" : "+v"(fr), "+v"(fq));
        const int row0 = u.pm * BM + wr * 64 + fr;
        float mu[2][4], rs[2][4];
        if (ln) ln_rows(st, row0, fq, mu, rs);
        u32x2 hold[2][4];
#pragma unroll
        for (int n = 0; n < 2; ++n) {
            const int R = u.pn * BM + wc * 32 + n * 16 + fq * 4;
            f32x4 c1g = {0.f, 0.f, 0.f, 0.f}, c2g = c1g, c1u = c1g, c2u = c1g;
            if (ln) { c1g = *(const f32x4*)(c1 + R); c2g = *(const f32x4*)(c2 + R); c1u = *(const f32x4*)(c1 + R + HALF); c2u = *(const f32x4*)(c2 + R + HALF); }
#pragma unroll
            for (int ai = 0; ai < 2; ++ai)
#pragma unroll
                for (int m = 0; m < 4; ++m) {
                    f32x4 yg = acc[ai][0][m][n], yu = acc[ai][1][m][n];
                    if (ln) { yg = (yg - c1g * mu[ai][m]) * rs[ai][m] + c2g; yu = (yu - c1u * mu[ai][m]) * rs[ai][m] + c2u; }
                    u32x2 w; w[0] = pk_bf16(silu_(yg[0]) * yu[0], silu_(yg[1]) * yu[1]); w[1] = pk_bf16(silu_(yg[2]) * yu[2], silu_(yg[3]) * yu[3]);
                    if (n == 0) hold[ai][m] = w;
                    else { const u32x4 w4 = {hold[ai][m][0], hold[ai][m][1], w[0], w[1]};
                           *(u32x4*)(h + (size_t)(row0 + ai * HALF + m * 16) * DFF + u.pn * HALF + wc * 32 + fq * 8) = w4; }
                }
        }
    }
};

struct EpiOut {
    float* pre; bf16_t* xb; const float* st_prev; float* st_new; const float* g; const float* b; const float* xp; const float* xs; float scale; int raw;
    __device__ __forceinline__ void operator()(const f32x4 (&acc)[2][2][4][2], const Unit& u, int wr, int wc, int fr_, int fq_) const {
        int fr = fr_, fq = fq_; asm volatile("" : "+v"(fr), "+v"(fq));
        const int row0 = u.pm * BM + wr * 64 + fr, col0 = u.pn * BM + wc * 32 + fq * 4;
        float mu[2][4], rs[2][4];
        if (!raw) ln_rows(st_prev, row0, fq, mu, rs);
        float s[2][4], q[2][4];
#pragma unroll
        for (int ai = 0; ai < 2; ++ai)
#pragma unroll
            for (int m = 0; m < 4; ++m) { s[ai][m] = 0.f; q[ai][m] = 0.f; }
        const float* xr = (u.pm < 64) ? xp : xs - (size_t)MP * DM;
#pragma unroll
        for (int bj = 0; bj < 2; ++bj)
#pragma unroll
            for (int n = 0; n < 2; ++n) {
                const int col = col0 + bj * HALF + n * 16;
                f32x4 g4 = {1.f, 1.f, 1.f, 1.f}, b4 = {0.f, 0.f, 0.f, 0.f};
                if (!raw) { g4 = *(const f32x4*)(g + col); b4 = *(const f32x4*)(b + col); }
#pragma unroll
                for (int ai = 0; ai < 2; ++ai)
#pragma unroll
                    for (int m = 0; m < 4; ++m) {
                        const size_t off = (size_t)(row0 + ai * HALF + m * 16) * DM + col;
                        f32x4 r4;
                        if (raw) r4 = *(const f32x4*)(xr + off);
                        else { const u32x2 pw = *(const u32x2*)(xb + off); const f32x4 p4 = {bflo(pw[0]), bfhi(pw[0]), bflo(pw[1]), bfhi(pw[1])}; r4 = (p4 - mu[ai][m]) * rs[ai][m] * g4 + b4; }
                        const f32x4 v = r4 * ALPHA + acc[ai][bj][m][n] * scale;
                        u32x2 w; w[0] = pk_bf16(v[0], v[1]); w[1] = pk_bf16(v[2], v[3]);
                        *(u32x2*)(xb + off) = w;
                        s[ai][m] += (v[0] + v[1]) + (v[2] + v[3]);
                        q[ai][m] += (v[0] * v[0] + v[1] * v[1]) + (v[2] * v[2] + v[3] * v[3]);
                    }
            }
#pragma unroll
        for (int ai = 0; ai < 2; ++ai)
#pragma unroll
            for (int m = 0; m < 4; ++m) {
                float ss = s[ai][m], qq = q[ai][m];
                ss += __shfl_xor(ss, 16); qq += __shfl_xor(qq, 16); ss += __shfl_xor(ss, 32); qq += __shfl_xor(qq, 32);
                if (fq == 0) *(f32x2*)(st_new + (size_t)(row0 + ai * HALF + m * 16) * 32 + (u.pn * 4 + wc) * 2) = (f32x2){ss, qq};
            }
    }
};

struct EpiRetIn {
    unsigned char* ws;
    __device__ __forceinline__ void operator()(const f32x4 (&acc)[2][2][4][2], const Unit& u, int wr, int wc, int fr_, int fq_) const {
        int fr = fr_, fq = fq_; asm volatile("" : "+v"(fr), "+v"(fq));
        bf16_t* const q = (bf16_t*)(ws + WS_ACT + A_Q); bf16_t* const k = (bf16_t*)(ws + WS_ACT + A_K); bf16_t* const kT = (bf16_t*)(ws + WS_ACT + A_KT);
        bf16_t* const vT = (bf16_t*)(ws + WS_ACT + A_VT); bf16_t* const vs = (bf16_t*)(ws + WS_ACT + A_VS); bf16_t* const sg = (bf16_t*)(ws + WS_ACT + A_SG);
        const float* const st = (const float*)(ws + WS_STATS); const float* const c1 = (const float*)(ws + WS_C_RETIN); const float* const c2 = c1 + NRET;
        const float* const cosn = (const float*)(ws + WS_COS); const float* const sinn = (const float*)(ws + WS_SIN);
        const float* const cost = (const float*)(ws + WS_COST); const float* const sint = (const float*)(ws + WS_SINT);
        if (!unit_swapped(u)) {
            const int row0 = u.pm * BM + wr * 64 + fr;
            if (u.pn < 8) {
                const int hd = u.pn & 3; bf16_t* dst = (u.pn < 4) ? q : k; const float osc = (u.pn < 4) ? 1.0f : 0.0625f;
#pragma unroll
                for (int ai = 0; ai < 2; ++ai) {
                    float mu[4], rs[4]; ln_rows4(st, row0 + ai * HALF, fq, mu, rs);
#pragma unroll
                    for (int n = 0; n < 2; ++n) {
                        const int j = wc * 32 + n * 16 + fq * 4, R = u.pn * BM + j;
                        const f32x4 c1a = *(const f32x4*)(c1 + R), c2a = *(const f32x4*)(c2 + R), c1b = *(const f32x4*)(c1 + R + HALF), c2b = *(const f32x4*)(c2 + R + HALF);
#pragma unroll
                        for (int m = 0; m < 4; ++m) {
                            const int row = row0 + ai * HALF + m * 16;
                            const int tr = row < MP ? (row & 2047) : 2048 + ((row - MP) & 3);
                            const f32x4 cs = *(const f32x4*)(cosn + tr * 128 + j), sn = *(const f32x4*)(sinn + tr * 128 + j);
                            const f32x4 y1 = ((acc[ai][0][m][n] - c1a * mu[m]) * rs[m] + c2a) * osc, y2 = ((acc[ai][1][m][n] - c1b * mu[m]) * rs[m] + c2b) * osc;
                            const f32x4 o1 = y1 * cs - y2 * sn, o2 = y1 * sn + y2 * cs;
                            u32x2 w1, w2; w1[0] = pk_bf16(o1[0], o1[1]); w1[1] = pk_bf16(o1[2], o1[3]); w2[0] = pk_bf16(o2[0], o2[1]); w2[1] = pk_bf16(o2[2], o2[3]);
                            bf16_t* pq = dst + (size_t)row * 1024 + hd * 256 + j;
                            *(u32x2*)pq = w1; *(u32x2*)(pq + HALF) = w2;
                            if (u.pn >= 4 && u.pm < 64) {
                                const float kdv = __builtin_amdgcn_exp2f((float)(127 - (row & 127)) * __builtin_amdgcn_logf(1.0f - __builtin_amdgcn_exp2f(-5.0f - (float)hd)));
                                bf16_t* pk = kT + (size_t)(hd * 256 + j) * MP + row;
#pragma unroll
                                for (int i = 0; i < 4; ++i) {
                                    pk[(size_t)i * MP] = (bf16_t)(pk_bf16(o1[i] * kdv, 0.f) & 0xffffu);
                                    pk[(size_t)(HALF + i) * MP] = (bf16_t)(pk_bf16(o2[i] * kdv, 0.f) & 0xffffu);
                                }
                            }
                            if (m & 1) asm volatile("" ::: "memory");
                        }
                    }
                }
            } else {
                const bool isv = u.pn < 16;
                bf16_t* dst = isv ? vs - (size_t)MP * 2048 + (size_t)(u.pn - 8) * BM : sg + (size_t)(u.pn - 16) * BM;
#pragma unroll
                for (int ai = 0; ai < 2; ++ai) {
                    float mu[4], rs[4]; ln_rows4(st, row0 + ai * HALF, fq, mu, rs);
#pragma unroll
                    for (int bj = 0; bj < 2; ++bj)
#pragma unroll
                        for (int n = 0; n < 2; ++n) {
                            const int cc = bj * HALF + wc * 32 + n * 16 + fq * 4, R = u.pn * BM + cc;
                            const f32x4 c1a = *(const f32x4*)(c1 + R), c2a = *(const f32x4*)(c2 + R);
#pragma unroll
                            for (int m = 0; m < 4; ++m) {
                                const int row = row0 + ai * HALF + m * 16;
                                f32x4 y = (acc[ai][bj][m][n] - c1a * mu[m]) * rs[m] + c2a;
                                if (!isv) { y[0] = silu_(y[0]); y[1] = silu_(y[1]); y[2] = silu_(y[2]); y[3] = silu_(y[3]); }
                                u32x2 w; w[0] = pk_bf16(y[0], y[1]); w[1] = pk_bf16(y[2], y[3]);
                                *(u32x2*)(dst + (size_t)row * 2048 + cc) = w;
                            }
                            asm volatile("" ::: "memory");
                        }
                }
            }
        } else {
            const int wpn = u.pn >= 24 ? u.pn - 20 : u.pn;
            const int Rl = wr * 64 + fr;
            if (u.pn >= 24) {
                const int hd = u.pn - 24;
                const float l2g = log2f(1.0f - exp2f(-5.0f - (float)hd));
#pragma unroll
                for (int bj = 0; bj < 2; ++bj)
#pragma unroll
                    for (int n = 0; n < 2; ++n) {
                        const int tok0 = u.pm * BM + bj * HALF + wc * 32 + n * 16 + fq * 4;
                        float mu[4], rs[4]; ln_tok4(st, tok0, fr, mu, rs);
                        const int pos0 = tok0 & 2047;
                        f32x4 kd;
#pragma unroll
                        for (int i = 0; i < 4; ++i) kd[i] = 0.0625f * exp2f((float)(127 - ((pos0 + i) & 127)) * l2g);
                        const f32x4 mu4 = {mu[0], mu[1], mu[2], mu[3]}, rs4 = {rs[0], rs[1], rs[2], rs[3]};
#pragma unroll
                        for (int m = 0; m < 4; ++m) {
                            const int j = Rl + m * 16, Ra = wpn * BM + j;
                            const float c1a = c1[Ra], c2a = c2[Ra], c1b = c1[Ra + HALF], c2b = c2[Ra + HALF];
                            const f32x4 cs = *(const f32x4*)(cost + j * 2048 + pos0), sn = *(const f32x4*)(sint + j * 2048 + pos0);
                            const f32x4 y1 = (acc[0][bj][m][n] - mu4 * c1a) * rs4 + c2a, y2 = (acc[1][bj][m][n] - mu4 * c1b) * rs4 + c2b;
                            const f32x4 o1 = (y1 * cs - y2 * sn) * kd, o2 = (y1 * sn + y2 * cs) * kd;
                            u32x2 w1, w2; w1[0] = pk_bf16(o1[0], o1[1]); w1[1] = pk_bf16(o1[2], o1[3]); w2[0] = pk_bf16(o2[0], o2[1]); w2[1] = pk_bf16(o2[2], o2[3]);
                            *(u32x2*)(kT + (size_t)(hd * 256 + j) * MP + tok0) = w1;
                            *(u32x2*)(kT + (size_t)(hd * 256 + HALF + j) * MP + tok0) = w2;
                            if (m & 1) asm volatile("" ::: "memory");
                        }
                    }
            } else {
                float c1v[2][4], c2v[2][4];
#pragma unroll
                for (int ai = 0; ai < 2; ++ai)
#pragma unroll
                    for (int m = 0; m < 4; ++m) { const int Ra = wpn * BM + ai * HALF + Rl + m * 16; c1v[ai][m] = c1[Ra]; c2v[ai][m] = c2[Ra]; }
#pragma unroll
                for (int bj = 0; bj < 2; ++bj)
#pragma unroll
                    for (int n = 0; n < 2; ++n) {
                        const int tok0 = u.pm * BM + bj * HALF + wc * 32 + n * 16 + fq * 4;
                        float mu[4], rs[4]; ln_tok4(st, tok0, fr, mu, rs);
                        const f32x4 mu4 = {mu[0], mu[1], mu[2], mu[3]}, rs4 = {rs[0], rs[1], rs[2], rs[3]};
#pragma unroll
                        for (int ai = 0; ai < 2; ++ai)
#pragma unroll
                            for (int m = 0; m < 4; ++m) {
                                const int rl = ai * HALF + Rl + m * 16;
                                const f32x4 y = (acc[ai][bj][m][n] - mu4 * c1v[ai][m]) * rs4 + c2v[ai][m];
                                u32x2 w; w[0] = pk_bf16(y[0], y[1]); w[1] = pk_bf16(y[2], y[3]);
                                *(u32x2*)(vT + (size_t)((u.pn - 8) * BM + rl) * MP + tok0) = w;
                            }
                        asm volatile("" ::: "memory");
                    }
            }
        }
    }
};

struct EpiRecIn {
    bf16_t* gate; float* xbr; float* out; const float* st; const float* c1; const float* c2;
    __device__ __forceinline__ void operator()(const f32x4 (&acc)[2][2][4][2], const Unit& u, int wr, int wc, int fr_, int fq_) const {
        int fr = fr_, fq = fq_; asm volatile("" : "+v"(fr), "+v"(fq));
        const int row0 = u.pm * BM + wr * 64 + fr;
        float mu[2][4], rs[2][4];
        ln_rows(st, row0, fq, mu, rs);
        const bool isg = u.pn < 5;
#pragma unroll
        for (int bj = 0; bj < 2; ++bj)
#pragma unroll
            for (int n = 0; n < 2; ++n) {
                const int R = u.pn * BM + bj * HALF + wc * 32 + n * 16 + fq * 4;
                const f32x4 c1a = *(const f32x4*)(c1 + R), c2a = *(const f32x4*)(c2 + R);
#pragma unroll
                for (int ai = 0; ai < 2; ++ai)
#pragma unroll
                    for (int m = 0; m < 4; ++m) {
                        const int row = row0 + ai * HALF + m * 16;
                        f32x4 y = (acc[ai][bj][m][n] - c1a * mu[ai][m]) * rs[ai][m] + c2a;
                        if (isg) {
                            u32x2 w; w[0] = pk_bf16(gelu_tanh_(y[0]), gelu_tanh_(y[1])); w[1] = pk_bf16(gelu_tanh_(y[2]), gelu_tanh_(y[3]));
                            *(u32x2*)(gate + (size_t)row * DRNN + R) = w;
                        } else {
                            const int ch = R - DRNN;
                            *(f32x4*)(xbr + (size_t)row * DRNN + ch) = y;
                            if (row < MP) { const int t = row & 2047; if (t >= 2045) *(f32x4*)(out + O_CONVP + (size_t)((row >> 11) * 3 + (t - 2045)) * DRNN + ch) = y; }
                            else { const int sr = row - MP, t = sr & 3; if (t >= 1) *(f32x4*)(out + O_CONVS + (size_t)((sr >> 2) * 3 + (t - 1)) * DRNN + ch) = y; }
                        }
                    }
            }
    }
};

__device__ __forceinline__ void prep_wtask(const float* W, int K, int N, int n0, int k0, int klen, bf16_t* Bt, int rbase, const float* g, const float* b, float* c1, float* c2, LAS unsigned char* lds, const int tid, const bool perm = false) {
    const int cn = tid & 63, kr = tid >> 6;
    LAS bf16_t* T = (LAS bf16_t*)lds;
    LAS float* red = (LAS float*)(lds + 16640);
    float c1a = 0.f, c2a = 0.f;
    float v[16], vn[16];
#pragma unroll
    for (int kk = 0; kk < 16; ++kk) v[kk] = W[(size_t)(k0 + kk * 8 + kr) * N + n0 + cn];
    for (int kb = k0; kb < k0 + klen; kb += 128) {
        if (kb + 128 < k0 + klen) {
#pragma unroll
            for (int kk = 0; kk < 16; ++kk) vn[kk] = W[(size_t)(kb + 128 + kk * 8 + kr) * N + n0 + cn];
        }
#pragma unroll
        for (int kk = 0; kk < 16; ++kk) {
            const int row = kb + kk * 8 + kr;
            float wv = v[kk];
            if (g) { wv = v[kk] * g[row]; c2a += v[kk] * b[row]; }
            const unsigned r = pk_bf16(wv, wv) & 0xffffu;
            if (g) c1a += __uint_as_float(r << 16);
            T[cn * 130 + kk * 8 + kr] = (bf16_t)r;
        }
        __syncthreads();
#pragma unroll
        for (int h2 = 0; h2 < 2; ++h2) {
            const int orow = tid >> 3, ch = (tid & 7) + h2 * 8;
            const LAS unsigned* src = (const LAS unsigned*)(T + orow * 130 + ch * 8);
            u32x4 w; w[0] = src[0]; w[1] = src[1]; w[2] = src[2]; w[3] = src[3];
            const int oslot = perm ? (orow & 32) + 16 * ((orow >> 2) & 1) + 4 * ((orow >> 3) & 3) + (orow & 3) : orow;
            *(u32x4*)(Bt + (size_t)(rbase + oslot) * K + kb + ch * 8) = w;
        }
        __syncthreads();
#pragma unroll
        for (int kk = 0; kk < 16; ++kk) v[kk] = vn[kk];
    }
    if (g) {
        red[kr * 64 + cn] = c1a; red[512 + kr * 64 + cn] = c2a;
        __syncthreads();
        if (tid < 64) { float s1 = 0.f, s2 = 0.f;
#pragma unroll
            for (int r = 0; r < 8; ++r) { s1 += red[r * 64 + tid]; s2 += red[512 + r * 64 + tid]; }
            const int cslot = perm ? (tid & 32) + 16 * ((tid >> 2) & 1) + 4 * ((tid >> 3) & 3) + (tid & 3) : tid;
            c1[rbase + cslot] = s1; c2[rbase + cslot] = s2; }
        __syncthreads();
    }
}
__device__ __forceinline__ int ffn_rowmap(int n0) { return n0 < DFF ? (n0 >> 7) * 256 + (n0 & 127) : ((n0 - DFF) >> 7) * 256 + 128 + ((n0 - DFF) & 127); }

__device__ __forceinline__ int prep_decode(int list, int a) {
    if (list == 1) {
        if (a < 88) return a;
        if (a < 176) return 176 + (a - 88);
        if (a < 208) return 488 + (a - 176);
        if (a < 240) return 552 + (a - 208);
        if (a < 240 + 2625) return 680 + (a - 240);
        return 4105;
    }
    if (list == 2) {
        if (a < 88) return 88 + a;
        if (a < 176) return 264 + (a - 88);
        if (a < 216) return 448 + (a - 176);
        if (a < 248) return 520 + (a - 216);
        if (a < 280) return 584 + (a - 248);
        if (a < 312) return 648 + (a - 280);
        if (a < 344) return 616 + (a - 312);
        return 3305 + (a - 344);
    }
    if (list == 3) return 352 + a;
    return a;
}
__device__ __forceinline__ void phase_prep(const Params& p, LAS unsigned char* lds, const int list, const int first, const int stride) {
    unsigned char* ws = p.ws;
    const int tid = otid();
    constexpr int T_FIN = 88 * 4, T_RETIN = 96, T_RECIN = 40, T_FOUT = 16 * 2 * 4, T_RETOUT = 32, T_RECOUT = 32;
    constexpr int T_W = T_FIN + T_RETIN + T_RECIN + T_FOUT + T_RETOUT + T_RECOUT;
    constexpr int T_X = (MT * DM) / 8192;
    constexpr int T_ROPE = 513, T_WAI = 800, T_MISC = 1;
    constexpr int T_ALL = T_W + T_X + T_ROPE + T_WAI + T_MISC;
    const int n_tasks = list == 0 ? T_ALL : list == 1 ? 2866 : list == 2 ? 1144 : 96;
    for (int a_ = first; a_ < n_tasks; a_ += stride) {
        const int t = prep_decode(list, a_);
        if (t < T_W) {
            int q = t;
            if (q < T_FIN) {
                const int w = q / 88, nt = q % 88;
                const float* W = (w < 2 ? p.ffn1_w_in : p.ffn2_w_in) + (size_t)(w & 1) * DM * NFF;
                bf16_t* Bt = (bf16_t*)(ws + (w == 0 ? WS_WF1IN0 : w == 1 ? WS_WF1IN1 : w == 2 ? WS_WF2IN0 : WS_WF2IN1));
                const float* g = nullptr; const float* b = nullptr; float* c1 = nullptr;
                if (w == 1) { g = p.ln_g + (0 * 3 + 2) * DM; b = p.ln_b + (0 * 3 + 2) * DM; c1 = (float*)(ws + WS_C_F1IN1); }
                if (w == 2) { g = p.ln_g + (0 * 3 + 1) * DM; b = p.ln_b + (0 * 3 + 1) * DM; c1 = (float*)(ws + WS_C_F2IN0); }
                if (w == 3) { g = p.ln_g + (1 * 3 + 1) * DM; b = p.ln_b + (1 * 3 + 1) * DM; c1 = (float*)(ws + WS_C_F2IN1); }
                prep_wtask(W, DM, NFF, nt * 64, 0, DM, Bt, ffn_rowmap(nt * 64), g, b, c1, c1 + NFF, lds, tid, true);
                continue;
            }
            q -= T_FIN;
            if (q < T_RETIN) { float* c1 = (float*)(ws + WS_C_RETIN);
                prep_wtask(p.ret_w_in, DM, NRET, q * 64, 0, DM, (bf16_t*)(ws + WS_WRETIN), q * 64, p.ln_g + 0, p.ln_b + 0, c1, c1 + NRET, lds, tid); continue; }
            q -= T_RETIN;
            if (q < T_RECIN) { float* c1 = (float*)(ws + WS_C_RECIN);
                prep_wtask(p.rec_w_in, DM, NREC, q * 64, 0, DM, (bf16_t*)(ws + WS_WRECIN), q * 64, p.ln_g + 3 * DM, p.ln_b + 3 * DM, c1, c1 + NREC, lds, tid); continue; }
            q -= T_RECIN;
            if (q < T_FOUT) {
                const int w = q / 32, r = q % 32, nt = r / 2, kc = r % 2;
                const float* W = (w < 2 ? p.ffn1_w_out : p.ffn2_w_out) + (size_t)(w & 1) * DFF * DM;
                bf16_t* Bt = (bf16_t*)(ws + (w == 0 ? WS_WF1OUT0 : w == 1 ? WS_WF1OUT1 : w == 2 ? WS_WF2OUT0 : WS_WF2OUT1));
                prep_wtask(W, DFF, DM, nt * 64, kc * 1408, 1408, Bt, nt * 64, nullptr, nullptr, nullptr, nullptr, lds, tid); continue;
            }
            q -= T_FOUT;
            if (q < T_RETOUT) { prep_wtask(p.ret_w_out, RV, DM, (q >> 1) * 64, (q & 1) * 1024, 1024, (bf16_t*)(ws + WS_WRETOUT), (q >> 1) * 64, nullptr, nullptr, nullptr, nullptr, lds, tid); continue; }
            q -= T_RETOUT;
            prep_wtask(p.rec_w_out, DRNN, DM, (q >> 1) * 64, (q & 1) * 640, 640, (bf16_t*)(ws + WS_WRECOUT), (q >> 1) * 64, nullptr, nullptr, nullptr, nullptr, lds, tid);
            continue;
        }
        int q = t - T_W;
        if (q < T_X) {
            const size_t e0 = (size_t)q * 8192 + (size_t)tid * 16;
            const float* src = e0 < (size_t)MP * DM ? p.x_prompt + e0 : p.x_sample + (e0 - (size_t)MP * DM);
            const f32x4 a = *(const f32x4*)src, b = *(const f32x4*)(src + 4), c = *(const f32x4*)(src + 8), d = *(const f32x4*)(src + 12);
            u32x4 w0, w1; w0[0] = pk_bf16(a[0], a[1]); w0[1] = pk_bf16(a[2], a[3]); w0[2] = pk_bf16(b[0], b[1]); w0[3] = pk_bf16(b[2], b[3]);
            w1[0] = pk_bf16(c[0], c[1]); w1[1] = pk_bf16(c[2], c[3]); w1[2] = pk_bf16(d[0], d[1]); w1[3] = pk_bf16(d[2], d[3]);
            bf16_t* dst = (bf16_t*)(ws + WS_XB16) + e0;
            *(u32x4*)dst = w0; *(u32x4*)(dst + 8) = w1;
            continue;
        }
        q -= T_X;
        if (q < T_ROPE) {
            const int tr = q * 4 + (tid >> 7), j = tid & 127;
            const int pos = tr < 2048 ? tr : 16384 + (tr - 2048);
            const float inv = exp2f(-(float)j * (13.287712379549449f / 128.0f));
            const float ang = (float)pos * inv;
            const double ad = (double)ang, nn = rint(ad * 0.15915494309189535), rr = ad - nn * 6.283185307179586;
            const float rf = (float)rr, cv = cosf(rf), sv = sinf(rf);
            ((float*)(ws + WS_COS))[tr * 128 + j] = cv; ((float*)(ws + WS_SIN))[tr * 128 + j] = sv;
            if (tr < 2048) { ((float*)(ws + WS_COST))[j * 2048 + tr] = cv; ((float*)(ws + WS_SINT))[j * 2048 + tr] = sv; }
            continue;
        }
        q -= T_ROPE;
        if (q < T_WAI) {
            const int e = q * 512 + tid;
            const int mat = e / 204800, r = e % 204800, nb = r / 25600, r2 = r % 25600, jj = r2 / 160, ii = r2 % 160;
            const float v = (mat ? p.rec_w_i : p.rec_w_a)[(size_t)nb * 25600 + ii * 160 + jj];
            ((bf16_t*)(ws + (mat ? WS_WI : WS_WA)))[(size_t)nb * 25600 + jj * 160 + ii] = (bf16_t)(pk_bf16(v, v) & 0xffffu);
            continue;
        }
        for (int i = tid; i < 64 * 16 * 16; i += NTHR) ((unsigned*)(ws + WS_FLAGS))[i] = 0u;
        for (int i = tid; i < DRNN; i += NTHR) { const float z = -p.rec_lam[i]; ((float*)(ws + WS_SPL))[i] = 8.0f * (fmaxf(z, 0.f) + log1pf(__expf(-fabsf(z)))); }
    }
}

__device__ __forceinline__ void ret_prompt_unit(const Params& p, int u, LAS unsigned char* lds) {
    const int tid = otid(), wid = tid >> 6, lane = tid & 63, fr = lane & 15, fq = lane >> 4;
    const int b = u >> 5, hd = (u >> 3) & 3, js = u & 7;
    const float l2g = log2f(1.0f - exp2f(-5.0f - (float)hd));
    constexpr int QH = 0, KH = 34816, KT = 0, ST = 69632, PP = 103424, VT = 138240;
    unsigned char* ws = p.ws;
    for (int i = tid; i < 33792 / 16; i += NTHR) *(LAS u32x4*)(lds + ST + i * 16) = (u32x4){0u, 0u, 0u, 0u};
    f32x4 S[2][4];
#pragma unroll
    for (int a = 0; a < 2; ++a)
#pragma unroll
        for (int c = 0; c < 4; ++c) S[a][c] = (f32x4){0.f, 0.f, 0.f, 0.f};
    const bf16_t* qg = (const bf16_t*)(ws + WS_ACT + A_Q) + (size_t)(b * 2048) * 1024 + hd * 256;
    const bf16_t* kg = (const bf16_t*)(ws + WS_ACT + A_K) + (size_t)(b * 2048) * 1024 + hd * 256;
    const bf16_t* ktg = (const bf16_t*)(ws + WS_ACT + A_KT) + (size_t)(hd * 256) * MP + b * 2048;
    const bf16_t* vtg = (const bf16_t*)(ws + WS_ACT + A_VT) + (size_t)(hd * 512 + js * 64) * MP + b * 2048;
    bf16_t* og = (bf16_t*)(ws + WS_ACT + A_O) + (size_t)(b * 2048) * 2048 + hd * 512 + js * 64;
    const int wm = wid >> 1, wn = wid & 1;
    const int sw = (((fr >> 2) ^ (fr >> 3)) & 1) << 4;
    const float cd = exp2f(128.0f * l2g);
    const float gam_inv = exp2f(-l2g); const float ginv[4] = {1.0f, gam_inv, gam_inv * gam_inv, gam_inv * gam_inv * gam_inv};
    u32x4 rq[4], rk[4], rv[2];
    const int lr = tid >> 4, lc = tid & 15;
    const int lcs = (lc * 16) ^ ((((lr >> 2) ^ (lr >> 3)) & 1) << 4);
#define RET_LD_QK(T0_, hh_) do { _Pragma("unroll") for (int it = 0; it < 4; ++it) { \
        rq[it] = *(const u32x4*)(qg + (size_t)((T0_) + lr + it * 32) * 1024 + (hh_) * 128 + lc * 8); \
        rk[it] = *(const u32x4*)(kg + (size_t)((T0_) + lr + it * 32) * 1024 + (hh_) * 128 + lc * 8); } } while (0)
#define RET_ST_QK() do { _Pragma("unroll") for (int it = 0; it < 4; ++it) { \
        *(LAS u32x4*)(lds + QH + (lr + it * 32) * 272 + lcs) = rq[it]; *(LAS u32x4*)(lds + KH + (lr + it * 32) * 272 + lcs) = rk[it]; } } while (0)
#define RET_LD_VT(T0_) do { _Pragma("unroll") for (int it = 0; it < 2; ++it) rv[it] = *(const u32x4*)(vtg + (size_t)(lr + it * 32) * MP + (T0_) + lc * 8); } while (0)
#define RET_ST_VT() do { _Pragma("unroll") for (int it = 0; it < 2; ++it) *(LAS u32x4*)(lds + VT + (lr + it * 32) * 272 + lcs) = rv[it]; } while (0)
#define RET_LD_KT(T0_) do { _Pragma("unroll") for (int it = 0; it < 4; ++it) { \
        rq[it] = *(const u32x4*)(ktg + (size_t)(lr + it * 32) * MP + (T0_) + lc * 8); rk[it] = *(const u32x4*)(ktg + (size_t)(128 + lr + it * 32) * MP + (T0_) + lc * 8); } } while (0)
#define RET_ST_KT() do { _Pragma("unroll") for (int it = 0; it < 4; ++it) { \
        *(LAS u32x4*)(lds + KT + (lr + it * 32) * 272 + lcs) = rq[it]; *(LAS u32x4*)(lds + KT + (128 + lr + it * 32) * 272 + lcs) = rk[it]; } } while (0)
    RET_LD_QK(0, 0); RET_LD_VT(0);
    __syncthreads();
    for (int c = 0; c < 16; ++c) {
        const int T0 = c * 128;
        f32x4 Pa[2][4], O1[2][2];
#pragma unroll
        for (int a = 0; a < 2; ++a) {
#pragma unroll
            for (int d = 0; d < 4; ++d) Pa[a][d] = (f32x4){0.f, 0.f, 0.f, 0.f};
            O1[a][0] = (f32x4){0.f, 0.f, 0.f, 0.f}; O1[a][1] = (f32x4){0.f, 0.f, 0.f, 0.f};
        }
        for (int hh = 0; hh < 2; ++hh) {
            RET_ST_QK();
            if (hh == 0) RET_ST_VT();
            __syncthreads();
            if (hh == 0) RET_LD_QK(T0, 1); else RET_LD_KT(T0);
#pragma unroll 1
            for (int ks = 0; ks < 4; ++ks) {
                bf16x8 qf[2], kf[4], sf[2];
#pragma unroll
                for (int mt = 0; mt < 2; ++mt) qf[mt] = *(const LAS bf16x8*)(lds + QH + (32 * wm + 16 * mt + fr) * 272 + ((ks * 64 + fq * 16) ^ sw));
#pragma unroll
                for (int nt = 0; nt < 4; ++nt) kf[nt] = *(const LAS bf16x8*)(lds + KH + (64 * wn + 16 * nt + fr) * 272 + ((ks * 64 + fq * 16) ^ sw));
#pragma unroll
                for (int n2 = 0; n2 < 2; ++n2) sf[n2] = *(const LAS bf16x8*)(lds + ST + (32 * wn + 16 * n2 + fr) * 528 + (((hh * 128 + ks * 32) * 2 + fq * 16) ^ sw));
#pragma unroll
                for (int mt = 0; mt < 2; ++mt) {
#pragma unroll
                    for (int nt = 0; nt < 4; ++nt) Pa[mt][nt] = mfma16(kf[nt], qf[mt], Pa[mt][nt]);
#pragma unroll
                    for (int n2 = 0; n2 < 2; ++n2) O1[mt][n2] = mfma16(sf[n2], qf[mt], O1[mt][n2]);
                }
            }
            __syncthreads();
        }
        int dl = 32 * wm + fr - 64 * wn - 4 * fq;
        asm volatile("" : "+v"(dl));
        {
            float rf[2], cf[4];
#pragma unroll
            for (int mt = 0; mt < 2; ++mt) rf[mt] = __builtin_amdgcn_exp2f((float)(32 * wm + 16 * mt + fr) * l2g);
#pragma unroll
            for (int nt = 0; nt < 4; ++nt) cf[nt] = __builtin_amdgcn_exp2f(-(float)(64 * wn + 16 * nt + 4 * fq) * l2g);
#pragma unroll
            for (int mt = 0; mt < 2; ++mt)
#pragma unroll
                for (int nt = 0; nt < 4; ++nt) {
                    const int cc = 32 * wm + 16 * mt + fr, e0 = 64 * wn + 16 * nt + 4 * fq;
                    const float rc = rf[mt] * cf[nt];
                    float v[4];
#pragma unroll
                    for (int i = 0; i < 4; ++i) { const int d = dl + 16 * mt - 16 * nt - i; v[i] = d >= 0 ? Pa[mt][nt][i] * (rc * ginv[i]) : 0.f; }
                    u32x2 w; w[0] = pk_bf16(v[0], v[1]); w[1] = pk_bf16(v[2], v[3]);
                    *(LAS u32x2*)(lds + PP + cc * 272 + ((e0 * 2) ^ sw)) = w;
                }
        }
        RET_ST_KT();
        __syncthreads();
        if (c < 15) { RET_LD_QK(T0 + 128, 0); RET_LD_VT(T0 + 128); }
#pragma unroll
        for (int mt = 0; mt < 2; ++mt) { const float qd = exp2f((float)(32 * wm + 16 * mt + fr + 1) * l2g); O1[mt][0] *= qd; O1[mt][1] *= qd; }
#pragma unroll
        for (int a = 0; a < 2; ++a)
#pragma unroll
            for (int d = 0; d < 4; ++d) S[a][d] *= cd;
#pragma unroll 1
        for (int ks = 0; ks < 4; ++ks) {
            bf16x8 pf[2], vf[2], af[2], bfr[4];
#pragma unroll
            for (int mt = 0; mt < 2; ++mt) pf[mt] = *(const LAS bf16x8*)(lds + PP + (32 * wm + 16 * mt + fr) * 272 + ((ks * 64 + fq * 16) ^ sw));
#pragma unroll
            for (int n2 = 0; n2 < 2; ++n2) vf[n2] = *(const LAS bf16x8*)(lds + VT + (32 * wn + 16 * n2 + fr) * 272 + ((ks * 64 + fq * 16) ^ sw));
#pragma unroll
            for (int mt = 0; mt < 2; ++mt) af[mt] = *(const LAS bf16x8*)(lds + KT + (32 * wid + 16 * mt + fr) * 272 + ((ks * 64 + fq * 16) ^ sw));
#pragma unroll
            for (int nt = 0; nt < 4; ++nt) bfr[nt] = *(const LAS bf16x8*)(lds + VT + (16 * nt + fr) * 272 + ((ks * 64 + fq * 16) ^ sw));
#pragma unroll
            for (int mt = 0; mt < 2; ++mt) {
#pragma unroll
                for (int n2 = 0; n2 < 2; ++n2) O1[mt][n2] = mfma16(vf[n2], pf[mt], O1[mt][n2]);
#pragma unroll
                for (int nt = 0; nt < 4; ++nt) S[mt][nt] = mfma16(af[mt], bfr[nt], S[mt][nt]);
            }
        }
#pragma unroll
        for (int mt = 0; mt < 2; ++mt)
#pragma unroll
            for (int n2 = 0; n2 < 2; ++n2) {
                u32x2 w; w[0] = pk_bf16(O1[mt][n2][0], O1[mt][n2][1]); w[1] = pk_bf16(O1[mt][n2][2], O1[mt][n2][3]);
                *(u32x2*)(og + (size_t)(T0 + 32 * wm + 16 * mt + fr) * 2048 + 32 * wn + 16 * n2 + 4 * fq) = w;
            }
#pragma unroll
        for (int mt = 0; mt < 2; ++mt)
#pragma unroll
            for (int nt = 0; nt < 4; ++nt) {
                u32x2 w; w[0] = pk_bf16(S[mt][nt][0], S[mt][nt][1]); w[1] = pk_bf16(S[mt][nt][2], S[mt][nt][3]);
                *(LAS u32x2*)(lds + ST + (16 * nt + fr) * 528 + (((32 * wid + 16 * mt + 4 * fq) * 2) ^ sw)) = w;
            }
        __syncthreads();
    }
#undef RET_LD_QK
#undef RET_ST_QK
#undef RET_LD_VT
#undef RET_ST_VT
#undef RET_LD_KT
#undef RET_ST_KT
    int soff = ((b * 4 + hd) * 256 + 32 * wid + 4 * fq) * 512 + js * 64 + fr;
    asm volatile("" : "+v"(soff));
    float* so = p.out + O_RETP + soff;
#pragma unroll
    for (int mt = 0; mt < 2; ++mt)
#pragma unroll
        for (int nt = 0; nt < 4; ++nt)
#pragma unroll
            for (int i = 0; i < 4; ++i) so[(16 * mt + i) * 512 + 16 * nt] = S[mt][nt][i];
}

template <int UNR>
__device__ __forceinline__ void ret_sample_unit(const Params& p, int u, LAS unsigned char* lds) {
    const int tid = otid(), wid = tid >> 6, lane = tid & 63;
    const int b = u >> 2, hd = u & 3;
    unsigned char* ws = p.ws;
    const float gam = 1.0f - exp2f(-5.0f - (float)hd);
    LAS float* qs = (LAS float*)lds;
    LAS float* ks = qs + 1024;
    LAS float* red = ks + 1024;
    LAS float* sc = red + 8192;
    LAS float* gs = sc + 16;
    const bf16_t* qg = (const bf16_t*)(ws + WS_ACT + A_Q) + (size_t)(MP + b * 4) * 1024 + hd * 256;
    const bf16_t* kg = (const bf16_t*)(ws + WS_ACT + A_K) + (size_t)(MP + b * 4) * 1024 + hd * 256;
    for (int i = tid; i < 1024; i += NTHR) { const int t = i >> 8, d = i & 255; qs[i] = bf2f(qg[(size_t)t * 1024 + d]); ks[i] = bf2f(kg[(size_t)t * 1024 + d]); }
    __syncthreads();
    {
        const int pair = tid >> 5, t = pair >> 2, e = pair & 3, l = tid & 31;
        float s = 0.f;
#pragma unroll
        for (int d = 0; d < 8; ++d) s += qs[t * 256 + l + d * 32] * ks[e * 256 + l + d * 32];
        s += __shfl_xor(s, 1); s += __shfl_xor(s, 2); s += __shfl_xor(s, 4); s += __shfl_xor(s, 8); s += __shfl_xor(s, 16);
        if (l == 0) { float dm = 0.f; if (e <= t) { dm = 1.f; for (int i = 0; i < t - e; ++i) dm *= gam; } sc[pair] = s * dm; }
    }
    const int cgi = tid & 127, rg = tid >> 7;
    const bf16_t* vg = (const bf16_t*)(ws + WS_ACT + A_VS) + (size_t)(b * 4) * 2048 + hd * 512 + cgi * 4;
    f32x4 v[4];
#pragma unroll
    for (int t = 0; t < 4; ++t) { const u32x2 w = *(const u32x2*)(vg + (size_t)t * 2048); v[t] = (f32x4){bflo(w[0]), bfhi(w[0]), bflo(w[1]), bfhi(w[1])}; }
    const float g2 = gam * gam, g3 = g2 * gam, g4 = g2 * g2;
    const float qdec[4] = {gam, g2, g3, g4}, kdec[4] = {g3, g2, gam, 1.0f};
    const float* s0 = p.state_ret + (size_t)((b * 4 + hd) * 256) * 512 + cgi * 4;
    float* sn = p.out + O_RETS + (size_t)((b * 4 + hd) * 256) * 512 + cgi * 4;
    f32x4 oa[4];
#pragma unroll
    for (int t = 0; t < 4; ++t) oa[t] = (f32x4){0.f, 0.f, 0.f, 0.f};
    {
        f32x4 bA[UNR], bB[UNR];
        const float* sp = s0 + (size_t)(rg * 64) * 512; float* dp = sn + (size_t)(rg * 64) * 512;
#define RS_LOAD(buf, base) do { _Pragma("unroll") for (int j = 0; j < UNR; ++j) buf[j] = __builtin_nontemporal_load((const f32x4*)(sp + (size_t)((base) + j) * 512)); } while (0)
#define RS_PROC(buf, base) do { _Pragma("unroll") for (int j = 0; j < UNR; ++j) { const int d = rg * 64 + (base) + j; const f32x4 s4 = buf[j]; f32x4 n4 = s4 * g4; \
            _Pragma("unroll") for (int t = 0; t < 4; ++t) { oa[t] += s4 * (qs[t * 256 + d] * qdec[t]); n4 += v[t] * (ks[t * 256 + d] * kdec[t]); } \
            __builtin_nontemporal_store(n4, (f32x4*)(dp + (size_t)((base) + j) * 512)); } } while (0)
        RS_LOAD(bA, 0);
#pragma unroll 1
        for (int base = 0; base < 64; base += 2 * UNR) {
            RS_LOAD(bB, base + UNR);
            RS_PROC(bA, base);
            if (base + 2 * UNR < 64) RS_LOAD(bA, base + 2 * UNR);
            RS_PROC(bB, base + UNR);
        }
#undef RS_LOAD
#undef RS_PROC
    }
#pragma unroll
    for (int t = 0; t < 4; ++t) *(LAS f32x4*)(red + (rg * 4 + t) * 512 + cgi * 4) = oa[t];
    __syncthreads();
    const int t = rg;
    f32x4 o4 = *(const LAS f32x4*)(red + (0 * 4 + t) * 512 + cgi * 4);
#pragma unroll
    for (int r = 1; r < 4; ++r) o4 += *(const LAS f32x4*)(red + (r * 4 + t) * 512 + cgi * 4);
#pragma unroll
    for (int e = 0; e < 4; ++e) o4 += v[e] * sc[t * 4 + e];
    float s = (o4[0] + o4[1]) + (o4[2] + o4[3]);
#pragma unroll
    for (int m = 1; m < 64; m <<= 1) s += __shfl_xor(s, m);
    if (lane == 0) gs[wid] = s;
    __syncthreads();
    const float mean = (gs[2 * t] + gs[2 * t + 1]) * (1.0f / 512.0f);
    const f32x4 dv = o4 - mean;
    float qv = (dv[0] * dv[0] + dv[1] * dv[1]) + (dv[2] * dv[2] + dv[3] * dv[3]);
#pragma unroll
    for (int m = 1; m < 64; m <<= 1) qv += __shfl_xor(qv, m);
    if (lane == 0) gs[8 + wid] = qv;
    __syncthreads();
    const float rstd = rsqrtf((gs[8 + 2 * t] + gs[8 + 2 * t + 1]) * (1.0f / 512.0f) + 1e-6f);
    const int row = MP + b * 4 + t, col = hd * 512 + cgi * 4;
    const f32x4 gg = *(const f32x4*)(p.ret_gn_g + col);
    const u32x2 sw = *(const u32x2*)((const bf16_t*)(ws + WS_ACT + A_SG) + (size_t)row * 2048 + col);
    const f32x4 sgv = {bflo(sw[0]), bfhi(sw[0]), bflo(sw[1]), bfhi(sw[1])};
    const f32x4 y = dv * rstd * gg * sgv;
    u32x2 w; w[0] = pk_bf16(y[0], y[1]); w[1] = pk_bf16(y[2], y[3]);
    *(u32x2*)((bf16_t*)(ws + WS_ACT + A_OG) + (size_t)row * 2048 + col) = w;
    __syncthreads();
}

__device__ __forceinline__ void phase_gn(const Params& p) {
    unsigned char* ws = p.ws;
    const int tid = otid(), wid = tid >> 6, lane = tid & 63;
    const bf16_t* o = (const bf16_t*)(ws + WS_ACT + A_O); const bf16_t* sg = (const bf16_t*)(ws + WS_ACT + A_SG); bf16_t* og = (bf16_t*)(ws + WS_ACT + A_OG);
    const int nb = gridDim.x == 256 ? 248 : (int)gridDim.x;
    for (int t0 = (p.vb * 8 + wid) * 4; t0 < MP * 4; t0 += nb * 32) {
        u32x4 ow[4], sw[4]; size_t off[4];
#pragma unroll
        for (int r = 0; r < 4; ++r) { const int t = t0 + r; off[r] = (size_t)(t >> 2) * 2048 + (t & 3) * 512 + lane * 8; ow[r] = *(const u32x4*)(o + off[r]); sw[r] = *(const u32x4*)(sg + off[r]); }
#pragma unroll
        for (int r = 0; r < 4; ++r) {
            const int hd = (t0 + r) & 3;
            float x[8];
#pragma unroll
            for (int i = 0; i < 4; ++i) { x[2 * i] = bflo(ow[r][i]); x[2 * i + 1] = bfhi(ow[r][i]); }
            float s = 0.f;
#pragma unroll
            for (int i = 0; i < 8; ++i) s += x[i];
#pragma unroll
            for (int m = 1; m < 64; m <<= 1) s += __shfl_xor(s, m);
            const float mean = s * (1.0f / 512.0f);
            float q = 0.f;
#pragma unroll
            for (int i = 0; i < 8; ++i) { x[i] -= mean; q += x[i] * x[i]; }
#pragma unroll
            for (int m = 1; m < 64; m <<= 1) q += __shfl_xor(q, m);
            const float rstd = rsqrtf(q * (1.0f / 512.0f) + 1e-6f);
            const f32x4 g0 = *(const f32x4*)(p.ret_gn_g + hd * 512 + lane * 8), g1 = *(const f32x4*)(p.ret_gn_g + hd * 512 + lane * 8 + 4);
            u32x4 w;
#pragma unroll
            for (int i = 0; i < 4; ++i) {
                const float ga = i < 2 ? g0[2 * i] : g1[2 * i - 4], gb = i < 2 ? g0[2 * i + 1] : g1[2 * i - 3];
                w[i] = pk_bf16(x[2 * i] * rstd * ga * bflo(sw[r][i]), x[2 * i + 1] * rstd * gb * bfhi(sw[r][i]));
            }
            *(u32x4*)(og + off[r]) = w;
        }
    }
}

__device__ __forceinline__ void rglru_unit(const Params& p, int u, LAS unsigned char* lds) {
    const int tid = otid(), wid = tid >> 6, lane = tid & 63, fr = lane & 15, fq = lane >> 4;
    unsigned char* ws = p.ws;
    constexpr int XA = 0, WA = 43008, WI = 96768, SUM = 150528, HIN = 160768, OUTB = 43008;
    const bool samp = u >= 1024;
    int nb, row_base, chain = 0, cidx = 0;
    if (!samp) { cidx = u >> 6; chain = u & 63; nb = chain & 7; row_base = (chain >> 3) * 2048 + cidx * 128; }
    else { const int su = u - 1024; nb = su & 7; row_base = MP + (su >> 3) * 128; }
    const float* xbr = (const float*)(ws + WS_ACT + A_XBR);
    {
        const bf16_t* wa = (const bf16_t*)(ws + WS_WA) + (size_t)nb * 25600; const bf16_t* wi = (const bf16_t*)(ws + WS_WI) + (size_t)nb * 25600;
        u32x4 ra[7], ri[7];
#pragma unroll
        for (int it = 0; it < 7; ++it) { const int i = tid + it * NTHR; if (i < 3200) { ra[it] = *(const u32x4*)(wa + i * 8); ri[it] = *(const u32x4*)(wi + i * 8); } }
#pragma unroll
        for (int it = 0; it < 7; ++it) { const int i = tid + it * NTHR; if (i < 3200) { const int r = i / 20, ch = i % 20;
            *(LAS u32x4*)(lds + WA + r * 336 + ch * 16) = ra[it]; *(LAS u32x4*)(lds + WI + r * 336 + ch * 16) = ri[it]; } }
    }
    if (tid < 480) {
        const int c4 = tid % 40, rg = tid / 40, ch = nb * 160 + c4 * 4, r0 = rg * 11;
        f32x4 xin[14];
#pragma unroll
        for (int j = 0; j < 14; ++j) {
            const int r = r0 + j - 3, row = row_base + r;
            f32x4 x = {0.f, 0.f, 0.f, 0.f};
            if (r < 128) {
                if (!samp) { if ((row_base & 2047) + r >= 0) x = *(const f32x4*)(xbr + (size_t)row * DRNN + ch); }
                else if (r >= 0) x = *(const f32x4*)(xbr + (size_t)row * DRNN + ch);
            }
            xin[j] = x;
        }
        const f32x4 cb = *(const f32x4*)(p.rec_conv_b + ch);
        f32x4 cw[4];
#pragma unroll
        for (int j = 0; j < 4; ++j) cw[j] = *(const f32x4*)(p.rec_conv_w + j * DRNN + ch);
#pragma unroll
        for (int k = 0; k < 11; ++k) {
            const int r = r0 + k;
            if (r < 128) {
                f32x4 a = cb;
                if (!samp) {
#pragma unroll
                    for (int j = 0; j < 4; ++j) a += cw[j] * xin[k + j];
                } else {
                    const int sr = row_base - MP + r, t = sr & 3, bb = sr >> 2;
#pragma unroll
                    for (int j = 0; j < 4; ++j) {
                        const int tj = t + j;
                        f32x4 x = xin[k + j];
                        if (tj < 3) x = *(const f32x4*)(p.state_conv + (size_t)(bb * 3 + tj) * DRNN + ch);
                        a += cw[j] * x;
                    }
                }
                u32x2 w2; w2[0] = pk_bf16(a[0], a[1]); w2[1] = pk_bf16(a[2], a[3]);
                *(LAS u32x2*)(lds + XA + r * 336 + c4 * 8) = w2;
            }
        }
    }
    __syncthreads();
    f32x4 ga[10], gi[10];
#pragma unroll
    for (int n = 0; n < 10; ++n) { ga[n] = (f32x4){0.f, 0.f, 0.f, 0.f}; gi[n] = (f32x4){0.f, 0.f, 0.f, 0.f}; }
#pragma unroll 1
    for (int ks = 0; ks < 5; ++ks) {
        const bf16x8 af = *(const LAS bf16x8*)(lds + XA + (16 * wid + fr) * 336 + ks * 64 + fq * 16);
#pragma unroll
        for (int n = 0; n < 10; ++n) {
            const bf16x8 ba = *(const LAS bf16x8*)(lds + WA + (16 * n + fr) * 336 + ks * 64 + fq * 16);
            const bf16x8 bi = *(const LAS bf16x8*)(lds + WI + (16 * n + fr) * 336 + ks * 64 + fq * 16);
            ga[n] = mfma16(af, ba, ga[n]); gi[n] = mfma16(af, bi, gi[n]);
        }
    }
#pragma unroll
    for (int n = 0; n < 10; ++n) {
        const int ch = 16 * n + fr, gch = nb * 160 + ch;
        const float ba = p.rec_b_a[gch], bi = p.rec_b_i[gch], spl = ((const float*)(ws + WS_SPL))[gch];
        float hinit = 0.f;
        if (samp) hinit = p.state_lru[(size_t)(((row_base - MP) >> 2) + 4 * wid + fq) * DRNN + gch];
        float Ac = 1.f, hc = hinit;
#pragma unroll
        for (int i = 0; i < 4; ++i) {
            const float r = sigmoid_(ga[n][i] + ba), ig = sigmoid_(gi[n][i] + bi);
            const float la = -spl * r, a = __expf(la);
            const float xc = bf2f(*(const LAS bf16_t*)(lds + XA + (16 * wid + 4 * fq + i) * 336 + ch * 2));
            const float uu = __builtin_amdgcn_sqrtf(fmaxf(__builtin_fmaf(-a, a, 1.0f), 0.f)) * (ig * xc);
            hc = a * hc + uu; Ac = a * Ac;
            ga[n][i] = Ac; gi[n][i] = hc;
        }
        asm volatile("" ::: "memory");
    }
    if (samp) {
#pragma unroll
        for (int n = 0; n < 10; ++n) p.out[O_LRUS + (size_t)(((row_base - MP) >> 2) + 4 * wid + fq) * DRNN + nb * 160 + 16 * n + fr] = gi[n][3];
    } else {
#pragma unroll
        for (int n = 0; n < 10; ++n) {
            float Ac = 1.f, hc = 0.f;
#pragma unroll
            for (int g = 0; g < 3; ++g) {
                const float Ag = __shfl(ga[n][3], g * 16 + fr), hg = __shfl(gi[n][3], g * 16 + fr);
                if (g < fq) { hc = Ag * hc + hg; Ac = Ag * Ac; }
            }
#pragma unroll
            for (int i = 0; i < 4; ++i) { gi[n][i] += ga[n][i] * hc; ga[n][i] *= Ac; }
            if (fq == 3) *(LAS f32x2*)(lds + SUM + ((wid * 160) + 16 * n + fr) * 8) = (f32x2){ga[n][3], gi[n][3]};
        }
        __syncthreads();
#pragma unroll
        for (int n = 0; n < 10; ++n) {
            float Ac = 1.f, hc = 0.f;
            for (int w = 0; w < wid; ++w) { const f32x2 sv = *(const LAS f32x2*)(lds + SUM + ((w * 160) + 16 * n + fr) * 8); hc = sv[0] * hc + sv[1]; Ac = sv[0] * Ac; }
#pragma unroll
            for (int i = 0; i < 4; ++i) { gi[n][i] += ga[n][i] * hc; ga[n][i] *= Ac; }
        }
        unsigned* flags = (unsigned*)(ws + WS_FLAGS); float* carry = (float*)(ws + WS_CARRY);
        if (tid < 160) {
            float Ac = 1.f, hc = 0.f;
            for (int w = 0; w < 8; ++w) { const f32x2 sv = *(const LAS f32x2*)(lds + SUM + ((w * 160) + tid) * 8); hc = sv[0] * hc + sv[1]; Ac = sv[0] * Ac; }
            float hin = 0.f;
            if (cidx > 0) {
                while (__hip_atomic_load(flags + (chain * 16 + cidx - 1) * 16, __ATOMIC_RELAXED, __HIP_MEMORY_SCOPE_AGENT) == 0u) __builtin_amdgcn_s_sleep(1);
                hin = __hip_atomic_load(carry + (size_t)(chain * 16 + cidx - 1) * 160 + tid, __ATOMIC_RELAXED, __HIP_MEMORY_SCOPE_AGENT);
            }
            const float hout = hc + Ac * hin;
            __hip_atomic_store(carry + (size_t)(chain * 16 + cidx) * 160 + tid, hout, __ATOMIC_RELAXED, __HIP_MEMORY_SCOPE_AGENT);
            *(LAS float*)(lds + HIN + tid * 4) = hin;
            if (cidx == 15) p.out[O_LRUP + (size_t)(chain >> 3) * DRNN + nb * 160 + tid] = hout;
        }
        asm volatile("s_waitcnt vmcnt(0)" ::: "memory");
        __syncthreads();
        if (tid == 0) __hip_atomic_store(flags + (chain * 16 + cidx) * 16, 1u, __ATOMIC_RELAXED, __HIP_MEMORY_SCOPE_AGENT);
#pragma unroll
        for (int n = 0; n < 10; ++n) { const float hin = *(const LAS float*)(lds + HIN + (16 * n + fr) * 4);
#pragma unroll
            for (int i = 0; i < 4; ++i) gi[n][i] += ga[n][i] * hin; }
    }
    __syncthreads();
#pragma unroll
    for (int n = 0; n < 10; ++n)
#pragma unroll
        for (int i = 0; i < 4; ++i) *(LAS float*)(lds + OUTB + ((16 * wid + 4 * fq + i) * 164 + 16 * n + fr) * 4) = gi[n][i];
    __syncthreads();
    {
        const bf16_t* gate = (const bf16_t*)(ws + WS_ACT + A_GATE); bf16_t* hg = (bf16_t*)(ws + WS_ACT + A_HG);
        for (int e = tid; e < 128 * 20; e += NTHR) {
            const int r = e / 20, c8 = e % 20; const size_t off = (size_t)(row_base + r) * DRNN + nb * 160 + c8 * 8;
            const u32x4 gw = *(const u32x4*)(gate + off);
            const f32x4 h0 = *(const LAS f32x4*)(lds + OUTB + (r * 164 + c8 * 8) * 4), h1 = *(const LAS f32x4*)(lds + OUTB + (r * 164 + c8 * 8 + 4) * 4);
            u32x4 w; w[0] = pk_bf16(h0[0] * bflo(gw[0]), h0[1] * bfhi(gw[0])); w[1] = pk_bf16(h0[2] * bflo(gw[1]), h0[3] * bfhi(gw[1]));
            w[2] = pk_bf16(h1[0] * bflo(gw[2]), h1[1] * bfhi(gw[2])); w[3] = pk_bf16(h1[2] * bflo(gw[3]), h1[3] * bfhi(gw[3]));
            *(u32x4*)(hg + off) = w;
        }
    }
    __syncthreads();
}

__device__ __forceinline__ void phase_final_ln(const Params& p) {
    const int tid = otid(), wid = tid >> 6, lane = tid & 63;
    const bf16_t* xb = (const bf16_t*)(p.ws + WS_XB16);
    const float* g = p.ln_g + 5 * DM; const float* b = p.ln_b + 5 * DM;
    for (int row = p.vb * 8 + wid; row < MT; row += gridDim.x * 8) {
        float x[16]; float s = 0.f;
#pragma unroll
        for (int k = 0; k < 2; ++k) { const u32x4 w = *(const u32x4*)(xb + (size_t)row * DM + k * 512 + lane * 8);
#pragma unroll
            for (int i = 0; i < 4; ++i) { x[k * 8 + 2 * i] = bflo(w[i]); x[k * 8 + 2 * i + 1] = bfhi(w[i]); } }
#pragma unroll
        for (int i = 0; i < 16; ++i) s += x[i];
#pragma unroll
        for (int m = 1; m < 64; m <<= 1) s += __shfl_xor(s, m);
        const float mean = s * (1.0f / 1024.0f); float q = 0.f;
#pragma unroll
        for (int i = 0; i < 16; ++i) { x[i] -= mean; q += x[i] * x[i]; }
#pragma unroll
        for (int m = 1; m < 64; m <<= 1) q += __shfl_xor(q, m);
        const float rstd = rsqrtf(q * (1.0f / 1024.0f) + 1e-5f);
#pragma unroll
        for (int k = 0; k < 2; ++k)
#pragma unroll
            for (int h2 = 0; h2 < 2; ++h2) { const int col = k * 512 + lane * 8 + h2 * 4;
                const f32x4 xv = {x[k * 8 + h2 * 4], x[k * 8 + h2 * 4 + 1], x[k * 8 + h2 * 4 + 2], x[k * 8 + h2 * 4 + 3]};
                *(f32x4*)(p.out + O_Y + (size_t)row * DM + col) = xv * rstd * *(const f32x4*)(g + col) + *(const f32x4*)(b + col); }
    }
}

constexpr int N_PHASES = 17;
__device__ __forceinline__ void grid_barrier(const Params& p, unsigned k) {
    asm volatile("s_waitcnt vmcnt(0)" ::: "memory");
    __syncthreads();
    if (p.wv == 0) {
        unsigned* bar = (unsigned*)(p.ws + WS_BAR);
        if (p.nloc == 0) {
            __builtin_amdgcn_fence(__ATOMIC_RELEASE, "agent");
            asm volatile("s_waitcnt vmcnt(0)" ::: "memory");
            const unsigned target = (k + 1u) * gridDim.x;
            if (__builtin_amdgcn_mbcnt_hi(~0u, __builtin_amdgcn_mbcnt_lo(~0u, 0u)) == 0u) {
                __hip_atomic_fetch_add(bar, 1u, __ATOMIC_RELAXED, __HIP_MEMORY_SCOPE_AGENT);
                while (__hip_atomic_load(bar, __ATOMIC_RELAXED, __HIP_MEMORY_SCOPE_AGENT) < target) __builtin_amdgcn_s_sleep(2);
            }
            __builtin_amdgcn_fence(__ATOMIC_ACQUIRE, "agent");
            asm volatile("s_waitcnt vmcnt(0)" ::: "memory");
        } else {
            const unsigned nloc = (unsigned)p.nloc, nx = (unsigned)p.nx, x = (unsigned)p.xcc;
            unsigned old = 0;
            if (__builtin_amdgcn_mbcnt_hi(~0u, __builtin_amdgcn_mbcnt_lo(~0u, 0u)) == 0u) old = __hip_atomic_fetch_add(bar + 128 + 16 * x, 1u, __ATOMIC_RELAXED, __HIP_MEMORY_SCOPE_AGENT);
            old = (unsigned)__builtin_amdgcn_readfirstlane((int)old);
            const unsigned gen = old / nloc;
            if (old + 1u == (gen + 1u) * nloc) {
                __builtin_amdgcn_fence(__ATOMIC_RELEASE, "agent");
                asm volatile("s_waitcnt vmcnt(0)" ::: "memory");
                unsigned og = 0;
                if (__builtin_amdgcn_mbcnt_hi(~0u, __builtin_amdgcn_mbcnt_lo(~0u, 0u)) == 0u) og = __hip_atomic_fetch_add(bar + 384, 1u, __ATOMIC_RELAXED, __HIP_MEMORY_SCOPE_AGENT);
                og = (unsigned)__builtin_amdgcn_readfirstlane((int)og);
                const unsigned tg = og / nx;
                if (og + 1u == (tg + 1u) * nx) { if (__builtin_amdgcn_mbcnt_hi(~0u, __builtin_amdgcn_mbcnt_lo(~0u, 0u)) == 0u) __hip_atomic_fetch_add(bar + 400, 1u, __ATOMIC_RELAXED, __HIP_MEMORY_SCOPE_AGENT); }
                else { while (__hip_atomic_load(bar + 400, __ATOMIC_RELAXED, __HIP_MEMORY_SCOPE_AGENT) == tg) __builtin_amdgcn_s_sleep(1); }
                __builtin_amdgcn_fence(__ATOMIC_ACQUIRE, "agent");
                if (__builtin_amdgcn_mbcnt_hi(~0u, __builtin_amdgcn_mbcnt_lo(~0u, 0u)) == 0u) __hip_atomic_fetch_add(bar + 256 + 16 * x, 1u, __ATOMIC_RELAXED, __HIP_MEMORY_SCOPE_AGENT);
                asm volatile("s_waitcnt vmcnt(0)" ::: "memory");
            } else {
                while (__hip_atomic_load(bar + 256 + 16 * x, __ATOMIC_RELAXED, __HIP_MEMORY_SCOPE_AGENT) == gen) __builtin_amdgcn_s_sleep(1);
                __builtin_amdgcn_fence(__ATOMIC_ACQUIRE, "agent");
                asm volatile("s_waitcnt vmcnt(0)" ::: "memory");
            }
        }
    }
    __syncthreads();
}
#define ST(i) ((float*)(ws + WS_STATS) + (size_t)(i) * (SZ_STATS / 4))
__device__ __forceinline__ EpiOut make_epi_ffn_out(const Params& p, int ph) {
    unsigned char* ws = p.ws;
    const int stp = ph == 8 ? 1 : ph == 10 ? 2 : 4, stn = ph == 2 ? 0 : ph == 8 ? 2 : ph == 10 ? 3 : 5;
    const int lni = ph == 8 ? 1 : ph == 10 ? 2 : 4;
    return EpiOut{(float*)(ws + WS_PRE), (bf16_t*)(ws + WS_XB16), ST(stp), ST(stn), p.ln_g + lni * DM, p.ln_b + lni * DM, p.x_prompt, p.x_sample, 0.5f, ph == 2};
}
__device__ __forceinline__ size_t ffn_out_w(int ph) { return ph == 2 ? WS_WF1OUT0 : ph == 8 ? WS_WF2OUT0 : ph == 10 ? WS_WF1OUT1 : WS_WF2OUT1; }
__device__ __forceinline__ void run_ffn_in(const Params& p, LAS unsigned char* lds, int ph) {
    unsigned char* ws = p.ws;
    const int layer = ph >= 9, second = (ph == 7 || ph == 14);
    const size_t wo = layer == 0 ? (second ? WS_WF2IN0 : WS_WF1IN0) : (second ? WS_WF2IN1 : WS_WF1IN1);
    const size_t co = ph == 7 ? WS_C_F2IN0 : ph == 9 ? WS_C_F1IN1 : WS_C_F2IN1;
    const int sti = ph == 7 ? 1 : ph == 9 ? 2 : 4;
    const bool special = gridDim.x == 256;
    unsigned* ctr = (unsigned*)(ws + WS_BAR) + 16 * (1 + (ph == 1 ? 0 : ph == 7 ? 1 : ph == 9 ? 2 : 3));
    Sched S; S.c = p.vb; S.init(ws + WS_XB16, ws + wo, MT, NFF, DM, 0); if (special) S.mode = 1;
    EpiFfnIn E{(bf16_t*)(ws + WS_ACT + A_H), ST(sti), (const float*)(ws + co), (const float*)(ws + co) + NFF, ph != 1};
    gemm_phase<false>(lds, S, E, p.wv, special ? ctr : nullptr);
    if (special && ph == 1 && p.vb >= 188 && p.vb < 248) phase_prep(p, lds, 3, p.vb - 188, 60);
    if (special && p.vb >= 248) {
        if (p.wv == 0) { while (__hip_atomic_load(ctr, __ATOMIC_RELAXED, __HIP_MEMORY_SCOPE_AGENT) < 44u * 8u) __builtin_amdgcn_s_sleep(8); }
        __syncthreads();
        __builtin_amdgcn_fence(__ATOMIC_ACQUIRE, "agent");
        asm volatile("s_waitcnt vmcnt(0)" ::: "memory");
        const int su = p.vb - 248;
        Sched S2; S2.c = p.vb; S2.init(ws + WS_ACT + A_H, ws + ffn_out_w(ph + 1), MT, DM, DFF, 0); S2.mode = 2; S2.upm = 64 + (su >> 2); S2.upn = su & 3;
        const EpiOut E2 = make_epi_ffn_out(p, ph + 1);
        gemm_phase<false>(lds, S2, E2, p.wv);
    }
}
__device__ __forceinline__ void run_ffn_out(const Params& p, LAS unsigned char* lds, int ph) {
    unsigned char* ws = p.ws;
    const bool special = gridDim.x == 256;
    Sched S; S.c = p.vb; S.init(ws + WS_ACT + A_H, ws + ffn_out_w(ph), special ? MP : MT, DM, DFF, 0);
    const EpiOut E = make_epi_ffn_out(p, ph);
    gemm_phase<false>(lds, S, E, p.wv);
}
__device__ __forceinline__ void run_mix_out(const Params& p, LAS unsigned char* lds, int ph, int M_rows, int only_sample_unit) {
    unsigned char* ws = p.ws;
    const bool ret = ph == 6;
    Sched S; S.c = p.vb; S.init(ws + WS_ACT + (ret ? A_OG : A_HG), ws + (ret ? WS_WRETOUT : WS_WRECOUT), M_rows, DM, ret ? RV : DRNN, 0);
    if (only_sample_unit >= 0) { S.mode = 2; S.upm = 64 + (only_sample_unit >> 2); S.upn = only_sample_unit & 3; }
    const int lni = ret ? 0 : 3;
    EpiOut E{(float*)(ws + WS_PRE), (bf16_t*)(ws + WS_XB16), ST(lni), ST(lni + 1), p.ln_g + lni * DM, p.ln_b + lni * DM, p.x_prompt, p.x_sample, 1.0f, 0};
    gemm_phase<false>(lds, S, E, p.wv);
}

__global__ void __launch_bounds__(NTHR) fwd_megakernel(Params p_) {
    Params p = p_; p.wv = __builtin_amdgcn_readfirstlane((int)(threadIdx.x >> 6));
    extern __shared__ __attribute__((aligned(16))) unsigned char lds_raw[];
    LAS unsigned char* lds = (LAS unsigned char*)lds_raw;
    const int lo = (int)p.ph_lo, hi = (int)p.ph_hi;
    p.vb = (int)blockIdx.x; p.xcc = 0; p.nloc = 0; p.nx = 0;
    if (hi - lo > 1) {
        unsigned* cen = (unsigned*)(p.ws + WS_BAR) + 96;
        const unsigned xcc = (unsigned)__builtin_amdgcn_s_getreg((3 << 11) | 20) & 0xFu;
        unsigned rank = 0;
        if (threadIdx.x == 0) rank = __hip_atomic_fetch_add(cen + (xcc & 7u), 1u, __ATOMIC_RELAXED, __HIP_MEMORY_SCOPE_AGENT);
        rank = (unsigned)__builtin_amdgcn_readfirstlane((int)rank);
        cg::this_grid().sync();
        bool ok = gridDim.x == 256 && xcc < 8u;
#pragma unroll
        for (int j = 0; j < 8; ++j) ok = ok && (__hip_atomic_load(cen + j, __ATOMIC_RELAXED, __HIP_MEMORY_SCOPE_AGENT) == 32u);
        LAS unsigned* sh = (LAS unsigned*)lds;
        if (threadIdx.x == 0) sh[0] = rank;
        __syncthreads();
        const unsigned r0 = sh[0];
        __syncthreads();
        if (ok) { p.vb = __builtin_amdgcn_readfirstlane((int)(r0 * 8u + xcc)); p.xcc = (int)xcc; p.nloc = 32; p.nx = 8; }
    }
    unsigned bk = 0;
#define PHASE(ph, ...) if (lo <= (ph) && (ph) < hi) { __VA_ARGS__; if ((ph) + 1 < hi) grid_barrier(p, bk++); }
    PHASE(0, phase_prep(p, lds, gridDim.x == 256 ? 1 : 0, p.vb, (int)gridDim.x))
    PHASE(1, run_ffn_in(p, lds, 1))
    PHASE(2, run_ffn_out(p, lds, 2))
    PHASE(3, { unsigned char* ws = p.ws; const bool special = gridDim.x == 256; unsigned* ctr = (unsigned*)(ws + WS_BAR) + 80;
               Sched S; S.c = p.vb; S.init(ws + WS_XB16, ws + WS_WRETIN, MT, NRET, DM, 0); if (special) S.mode = 3; EpiRetIn E{ws};
               if (!special) gemm_phase<true>(lds, S, E, p.wv, nullptr);
               else {
                   const int rb = 1 + (p.vb % 6);
                   S.iend = rb; gemm_phase<true>(lds, S, E, p.wv, ctr);
                   if (p.wv == 0) { while (__hip_atomic_load(ctr, __ATOMIC_RELAXED, __HIP_MEMORY_SCOPE_AGENT) < 48u * 8u) __builtin_amdgcn_s_sleep(8);
                                    __builtin_amdgcn_fence(__ATOMIC_ACQUIRE, "agent"); asm volatile("s_waitcnt vmcnt(0)" ::: "memory"); }
                   __syncthreads();
                   for (int su = p.vb; su < 512; su += 256) ret_sample_unit<8>(p, su, lds);
                   S.ibase = rb; S.iend = 1 << 20; gemm_phase<true>(lds, S, E, p.wv, ctr);
                   if (p.vb >= 48) phase_prep(p, lds, 2, p.vb - 48, 208);
               } })
    PHASE(4, { const int nu = gridDim.x == 256 ? 256 : 768; for (int u = p.vb; u < nu; u += gridDim.x) { if (u < 256) ret_prompt_unit(p, u, lds); else ret_sample_unit<4>(p, u - 256, lds); } })
    PHASE(5, { if (gridDim.x == 256 && p.vb >= 248) run_mix_out(p, lds, 6, MT, p.vb - 248); else phase_gn(p); })
    PHASE(6, run_mix_out(p, lds, 6, gridDim.x == 256 ? MP : MT, -1))
    PHASE(7, run_ffn_in(p, lds, 7))
    PHASE(8, run_ffn_out(p, lds, 8))
    PHASE(9, run_ffn_in(p, lds, 9))
    PHASE(10, run_ffn_out(p, lds, 10))
    PHASE(11, { unsigned char* ws = p.ws; const bool special = gridDim.x == 256; unsigned* ctr = (unsigned*)(ws + WS_BAR) + 112;
                Sched S; S.c = p.vb; S.init(ws + WS_XB16, ws + WS_WRECIN, MT, NREC, DM, 0); if (special) S.mode = 4;
                EpiRecIn E{(bf16_t*)(ws + WS_ACT + A_GATE), (float*)(ws + WS_ACT + A_XBR), p.out, ST(3), (const float*)(ws + WS_C_RECIN), (const float*)(ws + WS_C_RECIN) + NREC};
                gemm_phase<false>(lds, S, E, p.wv, special ? ctr : nullptr);
                if (special && p.vb >= 224) {
                    if (p.wv == 0) { while (__hip_atomic_load(ctr, __ATOMIC_RELAXED, __HIP_MEMORY_SCOPE_AGENT) < 20u * 8u) __builtin_amdgcn_s_sleep(8);
                                     __builtin_amdgcn_fence(__ATOMIC_ACQUIRE, "agent"); asm volatile("s_waitcnt vmcnt(0)" ::: "memory"); }
                    __syncthreads();
                    rglru_unit(p, 1024 + (p.vb - 224), lds);
                } })
    PHASE(12, { if (gridDim.x != 256) { for (int u = p.vb; u < 1056; u += gridDim.x) rglru_unit(p, u, lds); }
                else if (p.vb >= 248) { run_mix_out(p, lds, 13, MT, p.vb - 248); rglru_unit(p, p.vb + 512, lds); rglru_unit(p, p.vb + 768, lds); }
                else {
                    for (int sl = 0; sl < 5; ++sl) {
                        int u;
                        if (p.vb < 8) u = sl == 0 ? 248 + p.vb : p.vb + 256 * (sl - 1);
                        else if (p.vb < 16) u = sl == 0 ? p.vb : (sl == 1 ? 248 + (p.vb - 8) + 256 : p.vb + 256 * (sl - 1));
                        else u = sl < 4 ? p.vb + 256 * sl : -1;
                        if (u >= 0) rglru_unit(p, u, lds);
                    }
                } })
    PHASE(13, run_mix_out(p, lds, 13, gridDim.x == 256 ? MP : MT, -1))
    PHASE(14, run_ffn_in(p, lds, 14))
    PHASE(15, run_ffn_out(p, lds, 15))
    PHASE(16, phase_final_ln(p))
#undef PHASE
}
#undef ST

extern "C" void kernel_launch(void* const* d_in, const int* in_sizes, int n_in, void* d_out, int out_size, void* d_ws, size_t ws_size, hipStream_t stream) {
    static int grid = 0;
    if (grid == 0) {
        if (n_in != 23 || ws_size < WS_END) { fprintf(stderr, "kernel_launch: unexpected n_in %d or ws_size %zu (< %zu)\n", n_in, ws_size, (size_t)WS_END); grid = -1; return; }
        int dev = 0, cus = 0, per_cu = 0;
        hipGetDevice(&dev);
        hipDeviceGetAttribute(&cus, hipDeviceAttributeMultiprocessorCount, dev);
        if (hipFuncSetAttribute((const void*)fwd_megakernel, hipFuncAttributeMaxDynamicSharedMemorySize, LDS_BYTES) != hipSuccess) { fprintf(stderr, "kernel_launch: hipFuncSetAttribute failed\n"); grid = -1; return; }
        if (hipOccupancyMaxActiveBlocksPerMultiprocessor(&per_cu, (const void*)fwd_megakernel, NTHR, LDS_BYTES) != hipSuccess || per_cu < 1) { fprintf(stderr, "kernel_launch: occupancy query failed (%d)\n", per_cu); per_cu = 1; }
        (void)hipGetLastError();
        grid = cus * per_cu;
    }
    if (grid < 0) return;
    Params p{};
    const float** pp = (const float**)&p;
    for (int i = 0; i < 23; ++i) pp[i] = (const float*)d_in[i];
    p.out = (float*)d_out; p.ws = (unsigned char*)d_ws;
#if PER_PHASE_LAUNCH
    for (int ph = 0; ph < N_PHASES; ++ph) { p.ph_lo = ph; p.ph_hi = ph + 1; hipLaunchKernelGGL(fwd_megakernel, dim3(grid), dim3(NTHR), LDS_BYTES, stream, p); }
#else
    p.ph_lo = 0; p.ph_hi = N_PHASES;
    if (hipMemsetAsync((char*)d_ws + WS_BAR, 0, 2048, stream) != hipSuccess) { fprintf(stderr, "kernel_launch: memset of the barrier word failed\n"); return; }
    void* args[] = {&p};
    hipError_t e = hipLaunchCooperativeKernel((const void*)fwd_megakernel, dim3(grid), dim3(NTHR), args, LDS_BYTES, stream);
    if (e != hipSuccess) fprintf(stderr, "cooperative launch failed: %s (grid %d)\n", hipGetErrorString(e), grid);
#endif
}
```

```cpp
#include <hip/hip_runtime.h>
#include <hip/hip_cooperative_groups.h>
#include <cstdio>
namespace cg = cooperative_groups;

#ifndef PER_PHASE_LAUNCH
#define PER_PHASE_LAUNCH 0
#endif

#define LAS __attribute__((address_space(3)))
typedef unsigned short bf16_t;
typedef short bf16x8 __attribute__((ext_vector_type(8)));
typedef float f32x4 __attribute__((ext_vector_type(4)));
typedef float f32x2 __attribute__((ext_vector_type(2)));
typedef unsigned u32x2 __attribute__((ext_vector_type(2)));
typedef unsigned u32x4 __attribute__((ext_vector_type(4)));

constexpr int DM = 1024, MP = 16384, MS = 512, MT = 16896, DFF = 2816, NFF = 5632, RV = 2048, NRET = 6144, DRNN = 1280, NREC = 2560;
constexpr float ALPHA = 1.41421356237309515f;
constexpr int NTHR = 512;
constexpr int LDS_BYTES = 161792;

constexpr size_t O_Y = 0, O_RETP = 17301504, O_CONVP = 21495808, O_LRUP = 21526528, O_RETS = 21536768, O_CONVS = 88645632, O_LRUS = 89137152;

constexpr size_t al256(size_t x) { return (x + 255) & ~(size_t)255; }
constexpr size_t SZ_WFIN = (size_t)NFF * DM * 2, SZ_WFOUT = (size_t)DM * DFF * 2;
constexpr size_t WS_WF1IN0 = 0, WS_WF1IN1 = WS_WF1IN0 + SZ_WFIN, WS_WF2IN0 = WS_WF1IN1 + SZ_WFIN, WS_WF2IN1 = WS_WF2IN0 + SZ_WFIN;
constexpr size_t WS_WF1OUT0 = WS_WF2IN1 + SZ_WFIN, WS_WF1OUT1 = WS_WF1OUT0 + SZ_WFOUT, WS_WF2OUT0 = WS_WF1OUT1 + SZ_WFOUT, WS_WF2OUT1 = WS_WF2OUT0 + SZ_WFOUT;
constexpr size_t WS_WRETIN = WS_WF2OUT1 + SZ_WFOUT, WS_WRETOUT = WS_WRETIN + (size_t)NRET * DM * 2, WS_WRECIN = WS_WRETOUT + (size_t)DM * RV * 2;
constexpr size_t WS_WRECOUT = WS_WRECIN + (size_t)NREC * DM * 2, WS_WA = WS_WRECOUT + (size_t)DM * DRNN * 2, WS_WI = WS_WA + al256(8 * 160 * 160 * 2);
constexpr size_t WS_C_F1IN1 = WS_WI + al256(8 * 160 * 160 * 2);
constexpr size_t WS_C_F2IN0 = WS_C_F1IN1 + 2 * NFF * 4, WS_C_F2IN1 = WS_C_F2IN0 + 2 * NFF * 4, WS_C_RETIN = WS_C_F2IN1 + 2 * NFF * 4;
constexpr size_t WS_C_RECIN = WS_C_RETIN + 2 * NRET * 4;
constexpr size_t WS_COS = WS_C_RECIN + 2 * NREC * 4, WS_SIN = WS_COS + 2052 * 128 * 4, WS_COST = WS_SIN + 2052 * 128 * 4, WS_SINT = WS_COST + 128 * 2048 * 4;
constexpr size_t WS_FLAGS = WS_SINT + 128 * 2048 * 4;
constexpr size_t WS_CARRY = WS_FLAGS + 64 * 16 * 64;
constexpr size_t WS_SPL = WS_CARRY + 64 * 16 * 160 * 4;
constexpr size_t WS_BAR = WS_SPL + al256(DRNN * 4);
constexpr size_t WS_STATS = WS_BAR + 2048;
constexpr size_t SZ_STATS = (size_t)MT * 32 * 4;
constexpr size_t WS_XB16 = WS_STATS + 6 * SZ_STATS;
constexpr size_t WS_PRE = WS_XB16 + (size_t)MT * DM * 2;
constexpr size_t WS_ACT = WS_PRE + (size_t)MT * DM * 4;
constexpr size_t A_H = 0;
constexpr size_t A_Q = 0, A_K = A_Q + (size_t)MT * 1024 * 2, A_KT = A_K + (size_t)MT * 1024 * 2, A_VT = A_KT + (size_t)1024 * MP * 2;
constexpr size_t A_VS = A_VT + (size_t)2048 * MP * 2, A_SG = A_VS + (size_t)MS * 2048 * 2, A_O = A_SG + (size_t)MT * 2048 * 2, A_OG = A_O + (size_t)MP * 2048 * 2;
constexpr size_t A_END_RET = A_OG + (size_t)MT * 2048 * 2;
constexpr size_t A_GATE = 0, A_XBR = A_GATE + (size_t)MT * DRNN * 2, A_HG = A_XBR + (size_t)MT * DRNN * 4;
constexpr size_t WS_END = WS_ACT + A_END_RET;

struct Params {
    const float* x_prompt; const float* x_sample; const float* state_ret; const float* state_conv; const float* state_lru;
    const float* ln_g; const float* ln_b; const float* ffn1_w_in; const float* ffn1_w_out; const float* ffn2_w_in; const float* ffn2_w_out;
    const float* ret_w_in; const float* ret_gn_g; const float* ret_w_out; const float* rec_w_in; const float* rec_conv_w; const float* rec_conv_b;
    const float* rec_w_a; const float* rec_b_a; const float* rec_w_i; const float* rec_b_i; const float* rec_lam; const float* rec_w_out;
    float* out; unsigned char* ws; int ph_lo, ph_hi, wv, vb, xcc, nloc, nx, pad;
};

#define otid() otid_(p.wv)
__device__ __forceinline__ int otid_(int wv) { int t = wv * 64 + (int)__builtin_amdgcn_mbcnt_hi(~0u, __builtin_amdgcn_mbcnt_lo(~0u, 0u)); asm volatile("" : "+v"(t)); return t; }
__device__ __forceinline__ unsigned pk_bf16(float lo, float hi) { unsigned r; asm("v_cvt_pk_bf16_f32 %0, %1, %2" : "=v"(r) : "v"(lo), "v"(hi)); return r; }
__device__ __forceinline__ float bf2f(bf16_t b) { return __uint_as_float(((unsigned)b) << 16); }
__device__ __forceinline__ float bflo(unsigned w) { return __uint_as_float(w << 16); }
__device__ __forceinline__ float bfhi(unsigned w) { return __uint_as_float(w & 0xffff0000u); }
__device__ __forceinline__ float sigmoid_(float x) { return __builtin_amdgcn_rcpf(1.0f + __expf(-x)); }
__device__ __forceinline__ float silu_(float x) { return x * sigmoid_(x); }
__device__ __forceinline__ float gelu_tanh_(float x) { return x * sigmoid_(1.5957691216057308f * (x + 0.044715f * x * x * x)); }
__device__ __forceinline__ float one_minus_exp(float x) {
    const float ps = x * (1.f + x * (0.5f + x * (1.f / 6.f + x * (1.f / 24.f + x * (1.f / 120.f + x * (1.f / 720.f + x * (1.f / 5040.f)))))));
    const float e = 1.f - __expf(x);
    return x > -0.5f ? -ps : e;
}
__device__ __forceinline__ f32x4 mfma16(bf16x8 a, bf16x8 b, f32x4 c) { return __builtin_amdgcn_mfma_f32_16x16x32_bf16(a, b, c, 0, 0, 0); }

constexpr int BM = 256, BK = 64, HALF = 128, HTB = HALF * BK * 2, NXCD = 8, WGM = 8;
__device__ __forceinline__ int lds_byte(int r, int c) { const int st = (r >> 4) * 2 + (c >> 5), rr = r & 15, cc = c & 31, ob = rr * 64 + cc * 2; return st * 1024 + (ob ^ (((ob >> 9) & 1) << 5)); }
__device__ __forceinline__ void stage_rc(int b, int& R, int& C) { const int st = b / 1024, sb = b % 1024, swz = sb ^ (((sb >> 9) & 1) << 5); R = (st >> 1) * 16 + swz / 64; C = (st & 1) * 32 + (swz % 64) / 2; }

struct Unit { int pm, pn; };
struct Sched {
    const char* A; const char* B; int nM, nN, nwg, nExtra, K, G, c, mode, upm, upn, ntl, ibase, iend;
    __device__ __forceinline__ void init(const void* A_, const void* B_, int M, int N, int K_, int extra) {
        A = (const char*)A_; B = (const char*)B_; nM = M / BM; nN = N / BM; nwg = nM * nN; nExtra = extra; K = K_; G = gridDim.x; mode = 0; upm = 0; upn = 0; ntl = K_ / BK; ibase = 0; iend = 1 << 20; }
    __device__ __forceinline__ void std_map(int wgid, int nwg_, int nM_, Unit& u) const {
        { const int q = nwg_ / NXCD, r = nwg_ % NXCD, xcd = wgid % NXCD, off = wgid / NXCD; wgid = (xcd < r ? xcd * (q + 1) : r * (q + 1) + (xcd - r) * q) + off; }
        const int nig = WGM * nN, gid = wgid / nig, fm = gid * WGM, gsz = (nM_ - fm) < WGM ? (nM_ - fm) : WGM;
        u.pm = fm + ((wgid % nig) % gsz); u.pn = (wgid % nig) / gsz;
    }
    __device__ __forceinline__ bool next(int i, Unit& u) const {
        i += ibase; if (i >= iend) return false;
        if (mode == 2) { u.pm = upm; u.pn = upn; return i == 0; }
        if (mode == 1) {
            int L;
            if (c >= 248) { if (i >= 3) return false; L = i * 256 + c; }
            else if (i < 5) L = i * 256 + c;
            else if (i == 5) { if (c < 172) L = 1280 + c; else if (c < 188) L = (3 + ((c - 172) & 1)) * 256 + 248 + ((c - 172) >> 1); else return false; }
            else return false;
            if (L < 44) { u.pm = 64 + L / 22; u.pn = L % 22; return true; }
            std_map(L - 44, 1408, 64, u); return true;
        }
        if (mode == 4) {
            const int L4 = i * 256 + c; if (L4 >= 660) return false;
            if (L4 < 20) { u.pm = 64 + L4 / 10; u.pn = L4 % 10; return true; }
            std_map(L4 - 20, 640, 64, u); return true;
        }
        if (mode == 3) {
            const int L3 = i * 256 + c; if (L3 >= 1584) return false;
            if (L3 < 48) { u.pm = 64 + L3 / 24; u.pn = L3 % 24; return true; }
            std_map(L3 - 48, 1536, 64, u); return true;
        }
        const long L = (long)i * G + c; if (L >= nwg + nExtra) return false;
        if (L >= nwg) { const int e = (int)L - nwg; u.pm = e & 63; u.pn = 24 + (e >> 6); return true; }
        std_map((int)L, nwg, nM, u); return true;
    }
};
__device__ __forceinline__ bool unit_swapped(const Unit& u) { return (u.pn >= 24) || (u.pn >= 8 && u.pn < 16 && u.pm < 64); }

template <bool SWAP, class Epi>
__device__ __forceinline__ void gemm_phase(LAS unsigned char* lds, const Sched& S, const Epi& E, const int wv_, unsigned* done_ctr = nullptr) {
    const int tid = otid_(wv_), wid = __builtin_amdgcn_readfirstlane(tid >> 6), lane = tid & 63, wr = wid >> 2, wc = wid & 3, fr = lane & 15, fq = lane >> 4;
    const int K = S.K, nt = S.ntl;
    unsigned voff[2];
#pragma unroll
    for (int i = 0; i < 2; ++i) { int R, C; stage_rc(tid * 16 + i * 8192, R, C); voff[i] = (unsigned)(R * K + C) * 2u; }
    const size_t kstep = (size_t)(BK * 2);
    const size_t hstep = (size_t)HALF * K * 2;
    const size_t tstep = 2 * hstep;
    const unsigned ldsw = (unsigned)wid * 1024u;
    const int aoff = lds_byte(wr * 64 + fr, fq * 8), boff = lds_byte(wc * 32 + fr, fq * 8);
#define G_SA(b, h) (((b) * 2 + (h)) * HTB)
#define G_SB(b, h) ((4 + (b) * 2 + (h)) * HTB)
#define G_STAGE(bufoff, gbase) do { _Pragma("unroll") for (int _i = 0; _i < 2; ++_i) \
        __builtin_amdgcn_global_load_lds((const unsigned*)((const char*)(gbase) + voff[_i]), (LAS unsigned*)(lds + (bufoff) + ldsw + _i * 8192), 16, 0, 0); } while (0)
#define G_LDA(dst, b, h) do { _Pragma("unroll") for (int m = 0; m < 4; ++m) _Pragma("unroll") for (int k = 0; k < 2; ++k) dst[m][k] = *(const LAS bf16x8*)(lds + G_SA(b, h) + aoff + m * 2048 + k * 1024); } while (0)
#define G_LDB(dst, b, h) do { _Pragma("unroll") for (int n = 0; n < 2; ++n) _Pragma("unroll") for (int k = 0; k < 2; ++k) dst[n][k] = *(const LAS bf16x8*)(lds + G_SB(b, h) + boff + n * 2048 + k * 1024); } while (0)
#define G_MMA(ai, bj, At, Bt) do { __builtin_amdgcn_s_setprio(1); _Pragma("unroll") for (int m = 0; m < 4; ++m) _Pragma("unroll") for (int n = 0; n < 2; ++n) _Pragma("unroll") for (int k = 0; k < 2; ++k) \
        acc[ai][bj][m][n] = __builtin_amdgcn_mfma_f32_16x16x32_bf16(Bt[n][k], At[m][k], acc[ai][bj][m][n], 0, 0, 0); __builtin_amdgcn_s_setprio(0); } while (0)
#define G_WAIT_V(n) asm volatile("s_waitcnt vmcnt(" #n ")" ::: "memory")
#define G_WAIT_L(n) asm volatile("s_waitcnt lgkmcnt(" #n ")" ::: "memory")
#define G_BAR __builtin_amdgcn_s_barrier()
#define G_SCHED __builtin_amdgcn_sched_barrier(0)
#define G_PTRS(u, pa, pb) do { if (SWAP && unit_swapped(u)) { const int wpn = (u).pn >= 24 ? (u).pn - 20 : (u).pn; pa = S.B + (size_t)wpn * tstep; pb = S.A + (size_t)(u).pm * tstep; } \
        else { pa = S.A + (size_t)(u).pm * tstep; pb = S.B + (size_t)(u).pn * tstep; } } while (0)
    Unit cur, nxt; int ui = 0;
    if (!S.next(0, cur)) return;
    f32x4 acc[2][2][4][2];
#pragma unroll
    for (int a = 0; a < 2; ++a)
#pragma unroll
        for (int b = 0; b < 2; ++b)
#pragma unroll
            for (int m = 0; m < 4; ++m)
#pragma unroll
                for (int n = 0; n < 2; ++n) acc[a][b][m][n] = (f32x4){0.f, 0.f, 0.f, 0.f};
    bf16x8 At[4][2], B0[2][2], B1[2][2];
    const char* cA; const char* cB; G_PTRS(cur, cA, cB);
    G_STAGE(G_SB(0, 0), cB); G_STAGE(G_SA(0, 0), cA); G_STAGE(G_SB(0, 1), cB + hstep); G_STAGE(G_SA(0, 1), cA + hstep);
    if (wr == 1) G_BAR;
    G_WAIT_V(4); G_BAR;
    G_STAGE(G_SB(1, 0), cB + kstep); G_STAGE(G_SA(1, 0), cA + kstep); G_STAGE(G_SB(1, 1), cB + hstep + kstep);
    G_WAIT_V(6); G_BAR;
    for (;;) {
        const bool has_next = S.next(ui + 1, nxt);
        const char* nA = cA; const char* nB = cB;
        if (has_next) G_PTRS(nxt, nA, nB);
        for (int t = 0; t < nt; t += 2) {
            const bool last = (t == nt - 2);
            const char* a1 = cA + (size_t)(t + 1) * kstep;
            const char* a2 = last ? nA : cA + (size_t)(t + 2) * kstep; const char* b2 = last ? nB : cB + (size_t)(t + 2) * kstep;
            const char* a3 = a2 + kstep; const char* b3 = b2 + kstep;
            G_LDB(B0, 0, 0); G_SCHED; G_LDA(At, 0, 0); G_STAGE(G_SA(1, 1), a1 + hstep);
            G_WAIT_L(8); G_BAR; G_WAIT_L(0); G_MMA(0, 0, At, B0); G_BAR; G_SCHED;
            G_LDB(B1, 0, 1); G_STAGE(G_SB(0, 0), b2);
            G_BAR; G_WAIT_L(0); G_MMA(0, 1, At, B1); G_BAR;
            G_LDA(At, 0, 1); G_STAGE(G_SA(0, 0), a2);
            G_BAR; G_WAIT_L(0); G_MMA(1, 0, At, B0); G_BAR; G_SCHED;
            G_STAGE(G_SB(0, 1), b2 + hstep);
            G_WAIT_V(6); G_BAR; G_MMA(1, 1, At, B1); G_BAR;
            G_LDB(B0, 1, 0); G_SCHED; G_LDA(At, 1, 0); G_STAGE(G_SA(0, 1), a2 + hstep);
            G_WAIT_L(8); G_BAR; G_WAIT_L(0); G_MMA(0, 0, At, B0); G_BAR; G_SCHED;
            G_LDB(B1, 1, 1); G_STAGE(G_SB(1, 0), b3);
            G_BAR; G_WAIT_L(0); G_MMA(0, 1, At, B1); G_BAR;
            G_LDA(At, 1, 1); G_STAGE(G_SA(1, 0), a3);
            G_BAR; G_WAIT_L(0); G_MMA(1, 0, At, B0); G_BAR; G_SCHED;
            G_STAGE(G_SB(1, 1), b3 + hstep);
            G_WAIT_V(6); G_BAR; G_MMA(1, 1, At, B1); G_BAR;
        }
        E(acc, cur, wr, wc, fr, fq);
        if (done_ctr && cur.pm >= 64) {
            __builtin_amdgcn_fence(__ATOMIC_RELEASE, "agent");
            asm volatile("s_waitcnt vmcnt(0)" ::: "memory");
            if (lane == 0) __hip_atomic_fetch_add(done_ctr, 1u, __ATOMIC_RELAXED, __HIP_MEMORY_SCOPE_AGENT);
        }
        if (!has_next) break;
#pragma unroll
        for (int a = 0; a < 2; ++a)
#pragma unroll
            for (int b = 0; b < 2; ++b)
#pragma unroll
                for (int m = 0; m < 4; ++m)
#pragma unroll
                    for (int n = 0; n < 2; ++n) acc[a][b][m][n] = (f32x4){0.f, 0.f, 0.f, 0.f};
        cur = nxt; cA = nA; cB = nB; ++ui;
    }
    G_WAIT_V(0);
    if (wr == 0) G_BAR;
    G_BAR;
#undef G_SA
#undef G_SB
#undef G_STAGE
#undef G_LDA
#undef G_LDB
#undef G_MMA
#undef G_WAIT_V
#undef G_WAIT_L
#undef G_BAR
#undef G_SCHED
#undef G_PTRS
}

__device__ __forceinline__ void ln_rows(const float* st, int row0, int fq, float (&mu)[2][4], float (&rs)[2][4]) {
#pragma unroll
    for (int ai = 0; ai < 2; ++ai)
#pragma unroll
        for (int m = 0; m < 4; ++m) {
            const float* p = st + (unsigned)((row0 + ai * HALF + m * 16) * 32 + fq * 8);
            const f32x4 a = *(const f32x4*)p, b = *(const f32x4*)(p + 4);
            float s = (a[0] + a[2]) + (b[0] + b[2]), q = (a[1] + a[3]) + (b[1] + b[3]);
            s += __shfl_xor(s, 16); q += __shfl_xor(q, 16); s += __shfl_xor(s, 32); q += __shfl_xor(q, 32);
            const float mean = s * (1.0f / 1024.0f), var = q * (1.0f / 1024.0f) - mean * mean;
            mu[ai][m] = mean; rs[ai][m] = rsqrtf(var + 1e-5f);
            if (m == 3) asm volatile("" ::: "memory");
        }
}
__device__ __forceinline__ void ln_rows4(const float* st, int row0, int fq, float (&mu)[4], float (&rs)[4]) {
#pragma unroll
    for (int m = 0; m < 4; ++m) {
        const float* p = st + (unsigned)((row0 + m * 16) * 32 + fq * 8);
        const f32x4 a = *(const f32x4*)p, b = *(const f32x4*)(p + 4);
        float s = (a[0] + a[2]) + (b[0] + b[2]), q = (a[1] + a[3]) + (b[1] + b[3]);
        s += __shfl_xor(s, 16); q += __shfl_xor(q, 16); s += __shfl_xor(s, 32); q += __shfl_xor(q, 32);
        const float mean = s * (1.0f / 1024.0f), var = q * (1.0f / 1024.0f) - mean * mean;
        mu[m] = mean; rs[m] = rsqrtf(var + 1e-5f);
    }
    asm volatile("" ::: "memory");
}
__device__ __forceinline__ void ln_tok4(const float* st, int tok0, int fr, float (&mu)[4], float (&rs)[4]) {
#pragma unroll
    for (int i = 0; i < 4; ++i) {
        const f32x2 v = *(const f32x2*)(st + (unsigned)((tok0 + i) * 32 + fr * 2));
        float s = v[0], q = v[1];
        s += __shfl_xor(s, 1); q += __shfl_xor(q, 1); s += __shfl_xor(s, 2); q += __shfl_xor(q, 2);
        s += __shfl_xor(s, 4); q += __shfl_xor(q, 4); s += __shfl_xor(s, 8); q += __shfl_xor(q, 8);
        const float mean = s * (1.0f / 1024.0f), var = q * (1.0f / 1024.0f) - mean * mean;
        mu[i] = mean; rs[i] = rsqrtf(var + 1e-5f);
    }
}

struct EpiFfnIn {
    bf16_t* h; const float* st; const float* c1; const float* c2; int ln;
    __device__ __forceinline__ void operator()(const f32x4 (&acc)[2][2][4][2], const Unit& u, int wr, int wc, int fr_, int fq_) const {
        int fr = fr_, fq = fq_; asm volatile("" : "+v"(fr), "+v"(fq));
        const int row0 = u.pm * BM + wr * 64 + fr;
        float mu[2][4], rs[2][4];
        if (ln) ln_rows(st, row0, fq, mu, rs);
        u32x2 hold[2][4];
#pragma unroll
        for (int n = 0; n < 2; ++n) {
            const int R = u.pn * BM + wc * 32 + n * 16 + fq * 4;
            f32x4 c1g = {0.f, 0.f, 0.f, 0.f}, c2g = c1g, c1u = c1g, c2u = c1g;
            if (ln) { c1g = *(const f32x4*)(c1 + R); c2g = *(const f32x4*)(c2 + R); c1u = *(const f32x4*)(c1 + R + HALF); c2u = *(const f32x4*)(c2 + R + HALF); }
#pragma unroll
            for (int ai = 0; ai < 2; ++ai)
#pragma unroll
                for (int m = 0; m < 4; ++m) {
                    f32x4 yg = acc[ai][0][m][n], yu = acc[ai][1][m][n];
                    if (ln) { yg = (yg - c1g * mu[ai][m]) * rs[ai][m] + c2g; yu = (yu - c1u * mu[ai][m]) * rs[ai][m] + c2u; }
                    u32x2 w; w[0] = pk_bf16(silu_(yg[0]) * yu[0], silu_(yg[1]) * yu[1]); w[1] = pk_bf16(silu_(yg[2]) * yu[2], silu_(yg[3]) * yu[3]);
                    if (n == 0) hold[ai][m] = w;
                    else { const u32x4 w4 = {hold[ai][m][0], hold[ai][m][1], w[0], w[1]};
                           *(u32x4*)(h + (size_t)(row0 + ai * HALF + m * 16) * DFF + u.pn * HALF + wc * 32 + fq * 8) = w4; }
                }
        }
    }
};

struct EpiOut {
    float* pre; bf16_t* xb; const float* st_prev; float* st_new; const float* g; const float* b; const float* xp; const float* xs; float scale; int raw;
    __device__ __forceinline__ void operator()(const f32x4 (&acc)[2][2][4][2], const Unit& u, int wr, int wc, int fr_, int fq_) const {
        int fr = fr_, fq = fq_; asm volatile("" : "+v"(fr), "+v"(fq));
        const int row0 = u.pm * BM + wr * 64 + fr, col0 = u.pn * BM + wc * 32 + fq * 8;
        const float* xr = (u.pm < 64) ? xp : xs - (size_t)MP * DM;
#pragma unroll
        for (int ai = 0; ai < 2; ++ai) {
            float mu[4], rs[4];
            if (!raw) ln_rows4(st_prev, row0 + ai * HALF, fq, mu, rs);
            float s[4] = {0.f, 0.f, 0.f, 0.f}, q[4] = {0.f, 0.f, 0.f, 0.f};
#pragma unroll
            for (int bj = 0; bj < 2; ++bj) {
                const int col = col0 + bj * HALF;
                f32x4 g4a = {1.f, 1.f, 1.f, 1.f}, g4b = g4a, b4a = {0.f, 0.f, 0.f, 0.f}, b4b = b4a;
                if (!raw) { g4a = *(const f32x4*)(g + col); g4b = *(const f32x4*)(g + col + 4); b4a = *(const f32x4*)(b + col); b4b = *(const f32x4*)(b + col + 4); }
#pragma unroll
                for (int m = 0; m < 4; ++m) {
                    const size_t off = (size_t)(row0 + ai * HALF + m * 16) * DM + col;
                    f32x4 ra, rb;
                    if (raw) { ra = *(const f32x4*)(xr + off); rb = *(const f32x4*)(xr + off + 4); }
                    else { const u32x4 pw = *(const u32x4*)(xb + off);
                           const f32x4 pa = {bflo(pw[0]), bfhi(pw[0]), bflo(pw[1]), bfhi(pw[1])}, pb = {bflo(pw[2]), bfhi(pw[2]), bflo(pw[3]), bfhi(pw[3])};
                           ra = (pa - mu[m]) * rs[m] * g4a + b4a; rb = (pb - mu[m]) * rs[m] * g4b + b4b; }
                    const f32x4 va = ra * ALPHA + acc[ai][bj][m][0] * scale, vb = rb * ALPHA + acc[ai][bj][m][1] * scale;
                    u32x4 w; w[0] = pk_bf16(va[0], va[1]); w[1] = pk_bf16(va[2], va[3]); w[2] = pk_bf16(vb[0], vb[1]); w[3] = pk_bf16(vb[2], vb[3]);
                    *(u32x4*)(xb + off) = w;
                    s[m] += ((va[0] + va[1]) + (va[2] + va[3])) + ((vb[0] + vb[1]) + (vb[2] + vb[3]));
                    q[m] += ((va[0] * va[0] + va[1] * va[1]) + (va[2] * va[2] + va[3] * va[3])) + ((vb[0] * vb[0] + vb[1] * vb[1]) + (vb[2] * vb[2] + vb[3] * vb[3]));
                }
            }
#pragma unroll
            for (int m = 0; m < 4; ++m) {
                float ss = s[m], qq = q[m];
                ss += __shfl_xor(ss, 16); qq += __shfl_xor(qq, 16); ss += __shfl_xor(ss, 32); qq += __shfl_xor(qq, 32);
                if (fq == 0) *(f32x2*)(st_new + (size_t)(row0 + ai * HALF + m * 16) * 32 + (u.pn * 4 + wc) * 2) = (f32x2){ss, qq};
            }
        }
    }
};

struct EpiRetIn {
    unsigned char* ws;
    __device__ __forceinline__ void operator()(const f32x4 (&acc)[2][2][4][2], const Unit& u, int wr, int wc, int fr_, int fq_) const {
        int fr = fr_, fq = fq_; asm volatile("" : "+v"(fr), "+v"(fq));
        bf16_t* const q = (bf16_t*)(ws + WS_ACT + A_Q); bf16_t* const k = (bf16_t*)(ws + WS_ACT + A_K); bf16_t* const kT = (bf16_t*)(ws + WS_ACT + A_KT);
        bf16_t* const vT = (bf16_t*)(ws + WS_ACT + A_VT); bf16_t* const vs = (bf16_t*)(ws + WS_ACT + A_VS); bf16_t* const sg = (bf16_t*)(ws + WS_ACT + A_SG);
        const float* const st = (const float*)(ws + WS_STATS); const float* const c1 = (const float*)(ws + WS_C_RETIN); const float* const c2 = c1 + NRET;
        const float* const cosn = (const float*)(ws + WS_COS); const float* const sinn = (const float*)(ws + WS_SIN);
        const float* const cost = (const float*)(ws + WS_COST); const float* const sint = (const float*)(ws + WS_SINT);
        if (!unit_swapped(u)) {
            const int row0 = u.pm * BM + wr * 64 + fr;
            if (u.pn < 8) {
                const int hd = u.pn & 3; bf16_t* dst = (u.pn < 4) ? q : k; const float osc = (u.pn < 4) ? 1.0f : 0.0625f;
#pragma unroll
                for (int ai = 0; ai < 2; ++ai) {
                    float mu[4], rs[4]; ln_rows4(st, row0 + ai * HALF, fq, mu, rs);
#pragma unroll
                    for (int n = 0; n < 2; ++n) {
                        const int j = wc * 32 + n * 16 + fq * 4, R = u.pn * BM + j;
                        const f32x4 c1a = *(const f32x4*)(c1 + R), c2a = *(const f32x4*)(c2 + R), c1b = *(const f32x4*)(c1 + R + HALF), c2b = *(const f32x4*)(c2 + R + HALF);
#pragma unroll
                        for (int m = 0; m < 4; ++m) {
                            const int row = row0 + ai * HALF + m * 16;
                            const int tr = row < MP ? (row & 2047) : 2048 + ((row - MP) & 3);
                            const f32x4 cs = *(const f32x4*)(cosn + tr * 128 + j), sn = *(const f32x4*)(sinn + tr * 128 + j);
                            const f32x4 y1 = ((acc[ai][0][m][n] - c1a * mu[m]) * rs[m] + c2a) * osc, y2 = ((acc[ai][1][m][n] - c1b * mu[m]) * rs[m] + c2b) * osc;
                            const f32x4 o1 = y1 * cs - y2 * sn, o2 = y1 * sn + y2 * cs;
                            u32x2 w1, w2; w1[0] = pk_bf16(o1[0], o1[1]); w1[1] = pk_bf16(o1[2], o1[3]); w2[0] = pk_bf16(o2[0], o2[1]); w2[1] = pk_bf16(o2[2], o2[3]);
                            bf16_t* pq = dst + (size_t)row * 1024 + hd * 256 + j;
                            *(u32x2*)pq = w1; *(u32x2*)(pq + HALF) = w2;
                            if (u.pn >= 4 && u.pm < 64) {
                                const float kdv = __builtin_amdgcn_exp2f((float)(127 - (row & 127)) * __builtin_amdgcn_logf(1.0f - __builtin_amdgcn_exp2f(-5.0f - (float)hd)));
                                bf16_t* pk = kT + (size_t)(hd * 256 + j) * MP + row;
#pragma unroll
                                for (int i = 0; i < 4; ++i) {
                                    pk[(size_t)i * MP] = (bf16_t)(pk_bf16(o1[i] * kdv, 0.f) & 0xffffu);
                                    pk[(size_t)(HALF + i) * MP] = (bf16_t)(pk_bf16(o2[i] * kdv, 0.f) & 0xffffu);
                                }
                            }
                            if (m & 1) asm volatile("" ::: "memory");
                        }
                    }
                }
            } else {
                const bool isv = u.pn < 16;
                bf16_t* dst = isv ? vs - (size_t)MP * 2048 + (size_t)(u.pn - 8) * BM : sg + (size_t)(u.pn - 16) * BM;
#pragma unroll
                for (int ai = 0; ai < 2; ++ai) {
                    float mu[4], rs[4]; ln_rows4(st, row0 + ai * HALF, fq, mu, rs);
#pragma unroll
                    for (int bj = 0; bj < 2; ++bj)
#pragma unroll
                        for (int n = 0; n < 2; ++n) {
                            const int cc = bj * HALF + wc * 32 + n * 16 + fq * 4, R = u.pn * BM + cc;
                            const f32x4 c1a = *(const f32x4*)(c1 + R), c2a = *(const f32x4*)(c2 + R);
#pragma unroll
                            for (int m = 0; m < 4; ++m) {
                                const int row = row0 + ai * HALF + m * 16;
                                f32x4 y = (acc[ai][bj][m][n] - c1a * mu[m]) * rs[m] + c2a;
                                if (!isv) { y[0] = silu_(y[0]); y[1] = silu_(y[1]); y[2] = silu_(y[2]); y[3] = silu_(y[3]); }
                                u32x2 w; w[0] = pk_bf16(y[0], y[1]); w[1] = pk_bf16(y[2], y[3]);
                                *(u32x2*)(dst + (size_t)row * 2048 + cc) = w;
                            }
                            asm volatile("" ::: "memory");
                        }
                }
            }
        } else {
            const int wpn = u.pn >= 24 ? u.pn - 20 : u.pn;
            const int Rl = wr * 64 + fr;
            if (u.pn >= 24) {
                const int hd = u.pn - 24;
                const float l2g = log2f(1.0f - exp2f(-5.0f - (float)hd));
#pragma unroll
                for (int bj = 0; bj < 2; ++bj)
#pragma unroll
                    for (int n = 0; n < 2; ++n) {
                        const int tok0 = u.pm * BM + bj * HALF + wc * 32 + n * 16 + fq * 4;
                        float mu[4], rs[4]; ln_tok4(st, tok0, fr, mu, rs);
                        const int pos0 = tok0 & 2047;
                        f32x4 kd;
#pragma unroll
                        for (int i = 0; i < 4; ++i) kd[i] = 0.0625f * exp2f((float)(127 - ((pos0 + i) & 127)) * l2g);
                        const f32x4 mu4 = {mu[0], mu[1], mu[2], mu[3]}, rs4 = {rs[0], rs[1], rs[2], rs[3]};
#pragma unroll
                        for (int m = 0; m < 4; ++m) {
                            const int j = Rl + m * 16, Ra = wpn * BM + j;
                            const float c1a = c1[Ra], c2a = c2[Ra], c1b = c1[Ra + HALF], c2b = c2[Ra + HALF];
                            const f32x4 cs = *(const f32x4*)(cost + j * 2048 + pos0), sn = *(const f32x4*)(sint + j * 2048 + pos0);
                            const f32x4 y1 = (acc[0][bj][m][n] - mu4 * c1a) * rs4 + c2a, y2 = (acc[1][bj][m][n] - mu4 * c1b) * rs4 + c2b;
                            const f32x4 o1 = (y1 * cs - y2 * sn) * kd, o2 = (y1 * sn + y2 * cs) * kd;
                            u32x2 w1, w2; w1[0] = pk_bf16(o1[0], o1[1]); w1[1] = pk_bf16(o1[2], o1[3]); w2[0] = pk_bf16(o2[0], o2[1]); w2[1] = pk_bf16(o2[2], o2[3]);
                            *(u32x2*)(kT + (size_t)(hd * 256 + j) * MP + tok0) = w1;
                            *(u32x2*)(kT + (size_t)(hd * 256 + HALF + j) * MP + tok0) = w2;
                            if (m & 1) asm volatile("" ::: "memory");
                        }
                    }
            } else {
                float c1v[2][4], c2v[2][4];
#pragma unroll
                for (int ai = 0; ai < 2; ++ai)
#pragma unroll
                    for (int m = 0; m < 4; ++m) { const int Ra = wpn * BM + ai * HALF + Rl + m * 16; c1v[ai][m] = c1[Ra]; c2v[ai][m] = c2[Ra]; }
#pragma unroll
                for (int bj = 0; bj < 2; ++bj)
#pragma unroll
                    for (int n = 0; n < 2; ++n) {
                        const int tok0 = u.pm * BM + bj * HALF + wc * 32 + n * 16 + fq * 4;
                        float mu[4], rs[4]; ln_tok4(st, tok0, fr, mu, rs);
                        const f32x4 mu4 = {mu[0], mu[1], mu[2], mu[3]}, rs4 = {rs[0], rs[1], rs[2], rs[3]};
#pragma unroll
                        for (int ai = 0; ai < 2; ++ai)
#pragma unroll
                            for (int m = 0; m < 4; ++m) {
                                const int rl = ai * HALF + Rl + m * 16;
                                const f32x4 y = (acc[ai][bj][m][n] - mu4 * c1v[ai][m]) * rs4 + c2v[ai][m];
                                u32x2 w; w[0] = pk_bf16(y[0], y[1]); w[1] = pk_bf16(y[2], y[3]);
                                *(u32x2*)(vT + (size_t)((u.pn - 8) * BM + rl) * MP + tok0) = w;
                            }
                        asm volatile("" ::: "memory");
                    }
            }
        }
    }
};

struct EpiRecIn {
    bf16_t* gate; float* xbr; float* out; const float* st; const float* c1; const float* c2;
    __device__ __forceinline__ void operator()(const f32x4 (&acc)[2][2][4][2], const Unit& u, int wr, int wc, int fr_, int fq_) const {
        int fr = fr_, fq = fq_; asm volatile("" : "+v"(fr), "+v"(fq));
        const int row0 = u.pm * BM + wr * 64 + fr;
        float mu[2][4], rs[2][4];
        ln_rows(st, row0, fq, mu, rs);
        const bool isg = u.pn < 5;
#pragma unroll
        for (int bj = 0; bj < 2; ++bj)
#pragma unroll
            for (int n = 0; n < 2; ++n) {
                const int R = u.pn * BM + bj * HALF + wc * 32 + n * 16 + fq * 4;
                const f32x4 c1a = *(const f32x4*)(c1 + R), c2a = *(const f32x4*)(c2 + R);
#pragma unroll
                for (int ai = 0; ai < 2; ++ai)
#pragma unroll
                    for (int m = 0; m < 4; ++m) {
                        const int row = row0 + ai * HALF + m * 16;
                        f32x4 y = (acc[ai][bj][m][n] - c1a * mu[ai][m]) * rs[ai][m] + c2a;
                        if (isg) {
                            u32x2 w; w[0] = pk_bf16(gelu_tanh_(y[0]), gelu_tanh_(y[1])); w[1] = pk_bf16(gelu_tanh_(y[2]), gelu_tanh_(y[3]));
                            *(u32x2*)(gate + (size_t)row * DRNN + R) = w;
                        } else {
                            const int ch = R - DRNN;
                            *(f32x4*)(xbr + (size_t)row * DRNN + ch) = y;
                            if (row < MP) { const int t = row & 2047; if (t >= 2045) *(f32x4*)(out + O_CONVP + (size_t)((row >> 11) * 3 + (t - 2045)) * DRNN + ch) = y; }
                            else { const int sr = row - MP, t = sr & 3; if (t >= 1) *(f32x4*)(out + O_CONVS + (size_t)((sr >> 2) * 3 + (t - 1)) * DRNN + ch) = y; }
                        }
                    }
            }
    }
};

__device__ __forceinline__ void prep_wtask(const float* W, int K, int N, int n0, int k0, int klen, bf16_t* Bt, int rbase, const float* g, const float* b, float* c1, float* c2, LAS unsigned char* lds, const int tid, const bool perm = false) {
    const int cn = tid & 63, kr = tid >> 6;
    LAS bf16_t* T = (LAS bf16_t*)lds;
    LAS float* red = (LAS float*)(lds + 16640);
    float c1a = 0.f, c2a = 0.f;
    float v[16], vn[16];
#pragma unroll
    for (int kk = 0; kk < 16; ++kk) v[kk] = W[(size_t)(k0 + kk * 8 + kr) * N + n0 + cn];
    for (int kb = k0; kb < k0 + klen; kb += 128) {
        if (kb + 128 < k0 + klen) {
#pragma unroll
            for (int kk = 0; kk < 16; ++kk) vn[kk] = W[(size_t)(kb + 128 + kk * 8 + kr) * N + n0 + cn];
        }
#pragma unroll
        for (int kk = 0; kk < 16; ++kk) {
            const int row = kb + kk * 8 + kr;
            float wv = v[kk];
            if (g) { wv = v[kk] * g[row]; c2a += v[kk] * b[row]; }
            const unsigned r = pk_bf16(wv, wv) & 0xffffu;
            if (g) c1a += __uint_as_float(r << 16);
            T[cn * 130 + kk * 8 + kr] = (bf16_t)r;
        }
        __syncthreads();
#pragma unroll
        for (int h2 = 0; h2 < 2; ++h2) {
            const int orow = tid >> 3, ch = (tid & 7) + h2 * 8;
            const LAS unsigned* src = (const LAS unsigned*)(T + orow * 130 + ch * 8);
            u32x4 w; w[0] = src[0]; w[1] = src[1]; w[2] = src[2]; w[3] = src[3];
            const int oslot = perm ? (orow & 32) + 16 * ((orow >> 2) & 1) + 4 * ((orow >> 3) & 3) + (orow & 3) : orow;
            *(u32x4*)(Bt + (size_t)(rbase + oslot) * K + kb + ch * 8) = w;
        }
        __syncthreads();
#pragma unroll
        for (int kk = 0; kk < 16; ++kk) v[kk] = vn[kk];
    }
    if (g) {
        red[kr * 64 + cn] = c1a; red[512 + kr * 64 + cn] = c2a;
        __syncthreads();
        if (tid < 64) { float s1 = 0.f, s2 = 0.f;
#pragma unroll
            for (int r = 0; r < 8; ++r) { s1 += red[r * 64 + tid]; s2 += red[512 + r * 64 + tid]; }
            const int cslot = perm ? (tid & 32) + 16 * ((tid >> 2) & 1) + 4 * ((tid >> 3) & 3) + (tid & 3) : tid;
            c1[rbase + cslot] = s1; c2[rbase + cslot] = s2; }
        __syncthreads();
    }
}
__device__ __forceinline__ int ffn_rowmap(int n0) { return n0 < DFF ? (n0 >> 7) * 256 + (n0 & 127) : ((n0 - DFF) >> 7) * 256 + 128 + ((n0 - DFF) & 127); }

__device__ __forceinline__ int prep_decode(int list, int a) {
    if (list == 1) {
        if (a < 88) return a;
        if (a < 176) return 176 + (a - 88);
        if (a < 208) return 488 + (a - 176);
        if (a < 240) return 552 + (a - 208);
        if (a < 240 + 2625) return 680 + (a - 240);
        return 4105;
    }
    if (list == 2) {
        if (a < 88) return 88 + a;
        if (a < 176) return 264 + (a - 88);
        if (a < 216) return 448 + (a - 176);
        if (a < 248) return 520 + (a - 216);
        if (a < 280) return 584 + (a - 248);
        if (a < 312) return 648 + (a - 280);
        if (a < 344) return 616 + (a - 312);
        return 3305 + (a - 344);
    }
    if (list == 3) return 352 + a;
    return a;
}
__device__ __forceinline__ void phase_prep(const Params& p, LAS unsigned char* lds, const int list, const int first, const int stride) {
    unsigned char* ws = p.ws;
    const int tid = otid();
    constexpr int T_FIN = 88 * 4, T_RETIN = 96, T_RECIN = 40, T_FOUT = 16 * 2 * 4, T_RETOUT = 32, T_RECOUT = 32;
    constexpr int T_W = T_FIN + T_RETIN + T_RECIN + T_FOUT + T_RETOUT + T_RECOUT;
    constexpr int T_X = (MT * DM) / 8192;
    constexpr int T_ROPE = 513, T_WAI = 800, T_MISC = 1;
    constexpr int T_ALL = T_W + T_X + T_ROPE + T_WAI + T_MISC;
    const int n_tasks = list == 0 ? T_ALL : list == 1 ? 2866 : list == 2 ? 1144 : 96;
    for (int a_ = first; a_ < n_tasks; a_ += stride) {
        const int t = prep_decode(list, a_);
        if (t < T_W) {
            int q = t;
            if (q < T_FIN) {
                const int w = q / 88, nt = q % 88;
                const float* W = (w < 2 ? p.ffn1_w_in : p.ffn2_w_in) + (size_t)(w & 1) * DM * NFF;
                bf16_t* Bt = (bf16_t*)(ws + (w == 0 ? WS_WF1IN0 : w == 1 ? WS_WF1IN1 : w == 2 ? WS_WF2IN0 : WS_WF2IN1));
                const float* g = nullptr; const float* b = nullptr; float* c1 = nullptr;
                if (w == 1) { g = p.ln_g + (0 * 3 + 2) * DM; b = p.ln_b + (0 * 3 + 2) * DM; c1 = (float*)(ws + WS_C_F1IN1); }
                if (w == 2) { g = p.ln_g + (0 * 3 + 1) * DM; b = p.ln_b + (0 * 3 + 1) * DM; c1 = (float*)(ws + WS_C_F2IN0); }
                if (w == 3) { g = p.ln_g + (1 * 3 + 1) * DM; b = p.ln_b + (1 * 3 + 1) * DM; c1 = (float*)(ws + WS_C_F2IN1); }
                prep_wtask(W, DM, NFF, nt * 64, 0, DM, Bt, ffn_rowmap(nt * 64), g, b, c1, c1 + NFF, lds, tid, true);
                continue;
            }
            q -= T_FIN;
            if (q < T_RETIN) { float* c1 = (float*)(ws + WS_C_RETIN);
                prep_wtask(p.ret_w_in, DM, NRET, q * 64, 0, DM, (bf16_t*)(ws + WS_WRETIN), q * 64, p.ln_g + 0, p.ln_b + 0, c1, c1 + NRET, lds, tid); continue; }
            q -= T_RETIN;
            if (q < T_RECIN) { float* c1 = (float*)(ws + WS_C_RECIN);
                prep_wtask(p.rec_w_in, DM, NREC, q * 64, 0, DM, (bf16_t*)(ws + WS_WRECIN), q * 64, p.ln_g + 3 * DM, p.ln_b + 3 * DM, c1, c1 + NREC, lds, tid); continue; }
            q -= T_RECIN;
            if (q < T_FOUT) {
                const int w = q / 32, r = q % 32, nt = r / 2, kc = r % 2;
                const float* W = (w < 2 ? p.ffn1_w_out : p.ffn2_w_out) + (size_t)(w & 1) * DFF * DM;
                bf16_t* Bt = (bf16_t*)(ws + (w == 0 ? WS_WF1OUT0 : w == 1 ? WS_WF1OUT1 : w == 2 ? WS_WF2OUT0 : WS_WF2OUT1));
                prep_wtask(W, DFF, DM, nt * 64, kc * 1408, 1408, Bt, nt * 64, nullptr, nullptr, nullptr, nullptr, lds, tid, true); continue;
            }
            q -= T_FOUT;
            if (q < T_RETOUT) { prep_wtask(p.ret_w_out, RV, DM, (q >> 1) * 64, (q & 1) * 1024, 1024, (bf16_t*)(ws + WS_WRETOUT), (q >> 1) * 64, nullptr, nullptr, nullptr, nullptr, lds, tid, true); continue; }
            q -= T_RETOUT;
            prep_wtask(p.rec_w_out, DRNN, DM, (q >> 1) * 64, (q & 1) * 640, 640, (bf16_t*)(ws + WS_WRECOUT), (q >> 1) * 64, nullptr, nullptr, nullptr, nullptr, lds, tid, true);
            continue;
        }
        int q = t - T_W;
        if (q < T_X) {
            const size_t e0 = (size_t)q * 8192 + (size_t)tid * 16;
            const float* src = e0 < (size_t)MP * DM ? p.x_prompt + e0 : p.x_sample + (e0 - (size_t)MP * DM);
            const f32x4 a = *(const f32x4*)src, b = *(const f32x4*)(src + 4), c = *(const f32x4*)(src + 8), d = *(const f32x4*)(src + 12);
            u32x4 w0, w1; w0[0] = pk_bf16(a[0], a[1]); w0[1] = pk_bf16(a[2], a[3]); w0[2] = pk_bf16(b[0], b[1]); w0[3] = pk_bf16(b[2], b[3]);
            w1[0] = pk_bf16(c[0], c[1]); w1[1] = pk_bf16(c[2], c[3]); w1[2] = pk_bf16(d[0], d[1]); w1[3] = pk_bf16(d[2], d[3]);
            bf16_t* dst = (bf16_t*)(ws + WS_XB16) + e0;
            *(u32x4*)dst = w0; *(u32x4*)(dst + 8) = w1;
            continue;
        }
        q -= T_X;
        if (q < T_ROPE) {
            const int tr = q * 4 + (tid >> 7), j = tid & 127;
            const int pos = tr < 2048 ? tr : 16384 + (tr - 2048);
            const float inv = exp2f(-(float)j * (13.287712379549449f / 128.0f));
            const float ang = (float)pos * inv;
            const double ad = (double)ang, nn = rint(ad * 0.15915494309189535), rr = ad - nn * 6.283185307179586;
            const float rf = (float)rr, cv = cosf(rf), sv = sinf(rf);
            ((float*)(ws + WS_COS))[tr * 128 + j] = cv; ((float*)(ws + WS_SIN))[tr * 128 + j] = sv;
            if (tr < 2048) { ((float*)(ws + WS_COST))[j * 2048 + tr] = cv; ((float*)(ws + WS_SINT))[j * 2048 + tr] = sv; }
            continue;
        }
        q -= T_ROPE;
        if (q < T_WAI) {
            const int e = q * 512 + tid;
            const int mat = e / 204800, r = e % 204800, nb = r / 25600, r2 = r % 25600, jj = r2 / 160, ii = r2 % 160;
            const float v = (mat ? p.rec_w_i : p.rec_w_a)[(size_t)nb * 25600 + ii * 160 + jj];
            ((bf16_t*)(ws + (mat ? WS_WI : WS_WA)))[(size_t)nb * 25600 + jj * 160 + ii] = (bf16_t)(pk_bf16(v, v) & 0xffffu);
            continue;
        }
        for (int i = tid; i < 64 * 16 * 16; i += NTHR) ((unsigned*)(ws + WS_FLAGS))[i] = 0u;
        for (int i = tid; i < DRNN; i += NTHR) { const float z = -p.rec_lam[i]; ((float*)(ws + WS_SPL))[i] = 8.0f * (fmaxf(z, 0.f) + log1pf(__expf(-fabsf(z)))); }
    }
}

__device__ __forceinline__ void ret_prompt_unit(const Params& p, int u, LAS unsigned char* lds) {
    const int tid = otid(), wid = tid >> 6, lane = tid & 63, fr = lane & 15, fq = lane >> 4;
    const int b = u >> 5, hd = (u >> 3) & 3, js = u & 7;
    const float l2g = log2f(1.0f - exp2f(-5.0f - (float)hd));
    constexpr int QH = 0, KH = 34816, KT = 0, ST = 69632, PP = 103424, VT = 138240;
    unsigned char* ws = p.ws;
    for (int i = tid; i < 33792 / 16; i += NTHR) *(LAS u32x4*)(lds + ST + i * 16) = (u32x4){0u, 0u, 0u, 0u};
    f32x4 S[2][4];
#pragma unroll
    for (int a = 0; a < 2; ++a)
#pragma unroll
        for (int c = 0; c < 4; ++c) S[a][c] = (f32x4){0.f, 0.f, 0.f, 0.f};
    const bf16_t* qg = (const bf16_t*)(ws + WS_ACT + A_Q) + (size_t)(b * 2048) * 1024 + hd * 256;
    const bf16_t* kg = (const bf16_t*)(ws + WS_ACT + A_K) + (size_t)(b * 2048) * 1024 + hd * 256;
    const bf16_t* ktg = (const bf16_t*)(ws + WS_ACT + A_KT) + (size_t)(hd * 256) * MP + b * 2048;
    const bf16_t* vtg = (const bf16_t*)(ws + WS_ACT + A_VT) + (size_t)(hd * 512 + js * 64) * MP + b * 2048;
    bf16_t* og = (bf16_t*)(ws + WS_ACT + A_O) + (size_t)(b * 2048) * 2048 + hd * 512 + js * 64;
    const int wm = wid >> 1, wn = wid & 1;
    const int sw = (((fr >> 2) ^ (fr >> 3)) & 1) << 4;
    const float cd = exp2f(128.0f * l2g);
    const float gam_inv = exp2f(-l2g); const float ginv[4] = {1.0f, gam_inv, gam_inv * gam_inv, gam_inv * gam_inv * gam_inv};
    u32x4 rq[4], rk[4], rv[2];
    const int lr = tid >> 4, lc = tid & 15;
    const int lcs = (lc * 16) ^ ((((lr >> 2) ^ (lr >> 3)) & 1) << 4);
#define RET_LD_QK(T0_, hh_) do { _Pragma("unroll") for (int it = 0; it < 4; ++it) { \
        rq[it] = *(const u32x4*)(qg + (size_t)((T0_) + lr + it * 32) * 1024 + (hh_) * 128 + lc * 8); \
        rk[it] = *(const u32x4*)(kg + (size_t)((T0_) + lr + it * 32) * 1024 + (hh_) * 128 + lc * 8); } } while (0)
#define RET_ST_QK() do { _Pragma("unroll") for (int it = 0; it < 4; ++it) { \
        *(LAS u32x4*)(lds + QH + (lr + it * 32) * 272 + lcs) = rq[it]; *(LAS u32x4*)(lds + KH + (lr + it * 32) * 272 + lcs) = rk[it]; } } while (0)
#define RET_LD_VT(T0_) do { _Pragma("unroll") for (int it = 0; it < 2; ++it) rv[it] = *(const u32x4*)(vtg + (size_t)(lr + it * 32) * MP + (T0_) + lc * 8); } while (0)
#define RET_ST_VT() do { _Pragma("unroll") for (int it = 0; it < 2; ++it) *(LAS u32x4*)(lds + VT + (lr + it * 32) * 272 + lcs) = rv[it]; } while (0)
#define RET_LD_KT(T0_) do { _Pragma("unroll") for (int it = 0; it < 4; ++it) { \
        rq[it] = *(const u32x4*)(ktg + (size_t)(lr + it * 32) * MP + (T0_) + lc * 8); rk[it] = *(const u32x4*)(ktg + (size_t)(128 + lr + it * 32) * MP + (T0_) + lc * 8); } } while (0)
#define RET_ST_KT() do { _Pragma("unroll") for (int it = 0; it < 4; ++it) { \
        *(LAS u32x4*)(lds + KT + (lr + it * 32) * 272 + lcs) = rq[it]; *(LAS u32x4*)(lds + KT + (128 + lr + it * 32) * 272 + lcs) = rk[it]; } } while (0)
    RET_LD_QK(0, 0); RET_LD_VT(0);
    __syncthreads();
    for (int c = 0; c < 16; ++c) {
        const int T0 = c * 128;
        f32x4 Pa[2][4], O1[2][2];
#pragma unroll
        for (int a = 0; a < 2; ++a) {
#pragma unroll
            for (int d = 0; d < 4; ++d) Pa[a][d] = (f32x4){0.f, 0.f, 0.f, 0.f};
            O1[a][0] = (f32x4){0.f, 0.f, 0.f, 0.f}; O1[a][1] = (f32x4){0.f, 0.f, 0.f, 0.f};
        }
        for (int hh = 0; hh < 2; ++hh) {
            RET_ST_QK();
            if (hh == 0) RET_ST_VT();
            __syncthreads();
            if (hh == 0) RET_LD_QK(T0, 1); else RET_LD_KT(T0);
#pragma unroll 1
            for (int ks = 0; ks < 4; ++ks) {
                bf16x8 qf[2], kf[4], sf[2];
#pragma unroll
                for (int mt = 0; mt < 2; ++mt) qf[mt] = *(const LAS bf16x8*)(lds + QH + (32 * wm + 16 * mt + fr) * 272 + ((ks * 64 + fq * 16) ^ sw));
#pragma unroll
                for (int nt = 0; nt < 4; ++nt) kf[nt] = *(const LAS bf16x8*)(lds + KH + (64 * wn + 16 * nt + fr) * 272 + ((ks * 64 + fq * 16) ^ sw));
#pragma unroll
                for (int n2 = 0; n2 < 2; ++n2) sf[n2] = *(const LAS bf16x8*)(lds + ST + (32 * wn + 16 * n2 + fr) * 528 + (((hh * 128 + ks * 32) * 2 + fq * 16) ^ sw));
#pragma unroll
                for (int mt = 0; mt < 2; ++mt) {
#pragma unroll
                    for (int nt = 0; nt < 4; ++nt) Pa[mt][nt] = mfma16(kf[nt], qf[mt], Pa[mt][nt]);
#pragma unroll
                    for (int n2 = 0; n2 < 2; ++n2) O1[mt][n2] = mfma16(sf[n2], qf[mt], O1[mt][n2]);
                }
            }
            __syncthreads();
        }
        int dl = 32 * wm + fr - 64 * wn - 4 * fq;
        asm volatile("" : "+v"(dl));
        {
            float rf[2], cf[4];
#pragma unroll
            for (int mt = 0; mt < 2; ++mt) rf[mt] = __builtin_amdgcn_exp2f((float)(32 * wm + 16 * mt + fr) * l2g);
#pragma unroll
            for (int nt = 0; nt < 4; ++nt) cf[nt] = __builtin_amdgcn_exp2f(-(float)(64 * wn + 16 * nt + 4 * fq) * l2g);
#pragma unroll
            for (int mt = 0; mt < 2; ++mt)
#pragma unroll
                for (int nt = 0; nt < 4; ++nt) {
                    const int cc = 32 * wm + 16 * mt + fr, e0 = 64 * wn + 16 * nt + 4 * fq;
                    const float rc = rf[mt] * cf[nt];
                    float v[4];
#pragma unroll
                    for (int i = 0; i < 4; ++i) { const int d = dl + 16 * mt - 16 * nt - i; v[i] = d >= 0 ? Pa[mt][nt][i] * (rc * ginv[i]) : 0.f; }
                    u32x2 w; w[0] = pk_bf16(v[0], v[1]); w[1] = pk_bf16(v[2], v[3]);
                    *(LAS u32x2*)(lds + PP + cc * 272 + ((e0 * 2) ^ sw)) = w;
                }
        }
        RET_ST_KT();
        __syncthreads();
        if (c < 15) { RET_LD_QK(T0 + 128, 0); RET_LD_VT(T0 + 128); }
#pragma unroll
        for (int mt = 0; mt < 2; ++mt) { const float qd = exp2f((float)(32 * wm + 16 * mt + fr + 1) * l2g); O1[mt][0] *= qd; O1[mt][1] *= qd; }
#pragma unroll
        for (int a = 0; a < 2; ++a)
#pragma unroll
            for (int d = 0; d < 4; ++d) S[a][d] *= cd;
#pragma unroll 1
        for (int ks = 0; ks < 4; ++ks) {
            bf16x8 pf[2], vf[2], af[2], bfr[4];
#pragma unroll
            for (int mt = 0; mt < 2; ++mt) pf[mt] = *(const LAS bf16x8*)(lds + PP + (32 * wm + 16 * mt + fr) * 272 + ((ks * 64 + fq * 16) ^ sw));
#pragma unroll
            for (int n2 = 0; n2 < 2; ++n2) vf[n2] = *(const LAS bf16x8*)(lds + VT + (32 * wn + 16 * n2 + fr) * 272 + ((ks * 64 + fq * 16) ^ sw));
#pragma unroll
            for (int mt = 0; mt < 2; ++mt) af[mt] = *(const LAS bf16x8*)(lds + KT + (32 * wid + 16 * mt + fr) * 272 + ((ks * 64 + fq * 16) ^ sw));
#pragma unroll
            for (int nt = 0; nt < 4; ++nt) bfr[nt] = *(const LAS bf16x8*)(lds + VT + (16 * nt + fr) * 272 + ((ks * 64 + fq * 16) ^ sw));
#pragma unroll
            for (int mt = 0; mt < 2; ++mt) {
#pragma unroll
                for (int n2 = 0; n2 < 2; ++n2) O1[mt][n2] = mfma16(vf[n2], pf[mt], O1[mt][n2]);
#pragma unroll
                for (int nt = 0; nt < 4; ++nt) S[mt][nt] = mfma16(af[mt], bfr[nt], S[mt][nt]);
            }
        }
#pragma unroll
        for (int mt = 0; mt < 2; ++mt)
#pragma unroll
            for (int n2 = 0; n2 < 2; ++n2) {
                u32x2 w; w[0] = pk_bf16(O1[mt][n2][0], O1[mt][n2][1]); w[1] = pk_bf16(O1[mt][n2][2], O1[mt][n2][3]);
                *(u32x2*)(og + (size_t)(T0 + 32 * wm + 16 * mt + fr) * 2048 + 32 * wn + 16 * n2 + 4 * fq) = w;
            }
#pragma unroll
        for (int mt = 0; mt < 2; ++mt)
#pragma unroll
            for (int nt = 0; nt < 4; ++nt) {
                u32x2 w; w[0] = pk_bf16(S[mt][nt][0], S[mt][nt][1]); w[1] = pk_bf16(S[mt][nt][2], S[mt][nt][3]);
                *(LAS u32x2*)(lds + ST + (16 * nt + fr) * 528 + (((32 * wid + 16 * mt + 4 * fq) * 2) ^ sw)) = w;
            }
        __syncthreads();
    }
#undef RET_LD_QK
#undef RET_ST_QK
#undef RET_LD_VT
#undef RET_ST_VT
#undef RET_LD_KT
#undef RET_ST_KT
    int soff = ((b * 4 + hd) * 256 + 32 * wid + 4 * fq) * 512 + js * 64 + fr;
    asm volatile("" : "+v"(soff));
    float* so = p.out + O_RETP + soff;
#pragma unroll
    for (int mt = 0; mt < 2; ++mt)
#pragma unroll
        for (int nt = 0; nt < 4; ++nt)
#pragma unroll
            for (int i = 0; i < 4; ++i) so[(16 * mt + i) * 512 + 16 * nt] = S[mt][nt][i];
}

template <int UNR>
__device__ __forceinline__ void ret_sample_unit(const Params& p, int u, LAS unsigned char* lds) {
    const int tid = otid(), wid = tid >> 6, lane = tid & 63;
    const int b = u >> 2, hd = u & 3;
    unsigned char* ws = p.ws;
    const float gam = 1.0f - exp2f(-5.0f - (float)hd);
    LAS float* qs = (LAS float*)lds;
    LAS float* ks = qs + 1024;
    LAS float* red = ks + 1024;
    LAS float* sc = red + 8192;
    LAS float* gs = sc + 16;
    const bf16_t* qg = (const bf16_t*)(ws + WS_ACT + A_Q) + (size_t)(MP + b * 4) * 1024 + hd * 256;
    const bf16_t* kg = (const bf16_t*)(ws + WS_ACT + A_K) + (size_t)(MP + b * 4) * 1024 + hd * 256;
    for (int i = tid; i < 1024; i += NTHR) { const int t = i >> 8, d = i & 255; qs[i] = bf2f(qg[(size_t)t * 1024 + d]); ks[i] = bf2f(kg[(size_t)t * 1024 + d]); }
    __syncthreads();
    {
        const int pair = tid >> 5, t = pair >> 2, e = pair & 3, l = tid & 31;
        float s = 0.f;
#pragma unroll
        for (int d = 0; d < 8; ++d) s += qs[t * 256 + l + d * 32] * ks[e * 256 + l + d * 32];
        s += __shfl_xor(s, 1); s += __shfl_xor(s, 2); s += __shfl_xor(s, 4); s += __shfl_xor(s, 8); s += __shfl_xor(s, 16);
        if (l == 0) { float dm = 0.f; if (e <= t) { dm = 1.f; for (int i = 0; i < t - e; ++i) dm *= gam; } sc[pair] = s * dm; }
    }
    const int cgi = tid & 127, rg = tid >> 7;
    const bf16_t* vg = (const bf16_t*)(ws + WS_ACT + A_VS) + (size_t)(b * 4) * 2048 + hd * 512 + cgi * 4;
    f32x4 v[4];
#pragma unroll
    for (int t = 0; t < 4; ++t) { const u32x2 w = *(const u32x2*)(vg + (size_t)t * 2048); v[t] = (f32x4){bflo(w[0]), bfhi(w[0]), bflo(w[1]), bfhi(w[1])}; }
    const float g2 = gam * gam, g3 = g2 * gam, g4 = g2 * g2;
    const float qdec[4] = {gam, g2, g3, g4}, kdec[4] = {g3, g2, gam, 1.0f};
    const float* s0 = p.state_ret + (size_t)((b * 4 + hd) * 256) * 512 + cgi * 4;
    float* sn = p.out + O_RETS + (size_t)((b * 4 + hd) * 256) * 512 + cgi * 4;
    f32x4 oa[4];
#pragma unroll
    for (int t = 0; t < 4; ++t) oa[t] = (f32x4){0.f, 0.f, 0.f, 0.f};
    {
        f32x4 bA[UNR], bB[UNR];
        const float* sp = s0 + (size_t)(rg * 64) * 512; float* dp = sn + (size_t)(rg * 64) * 512;
#define RS_LOAD(buf, base) do { _Pragma("unroll") for (int j = 0; j < UNR; ++j) buf[j] = __builtin_nontemporal_load((const f32x4*)(sp + (size_t)((base) + j) * 512)); } while (0)
#define RS_PROC(buf, base) do { _Pragma("unroll") for (int j = 0; j < UNR; ++j) { const int d = rg * 64 + (base) + j; const f32x4 s4 = buf[j]; f32x4 n4 = s4 * g4; \
            _Pragma("unroll") for (int t = 0; t < 4; ++t) { oa[t] += s4 * (qs[t * 256 + d] * qdec[t]); n4 += v[t] * (ks[t * 256 + d] * kdec[t]); } \
            __builtin_nontemporal_store(n4, (f32x4*)(dp + (size_t)((base) + j) * 512)); } } while (0)
        RS_LOAD(bA, 0);
#pragma unroll 1
        for (int base = 0; base < 64; base += 2 * UNR) {
            RS_LOAD(bB, base + UNR);
            RS_PROC(bA, base);
            if (base + 2 * UNR < 64) RS_LOAD(bA, base + 2 * UNR);
            RS_PROC(bB, base + UNR);
        }
#undef RS_LOAD
#undef RS_PROC
    }
#pragma unroll
    for (int t = 0; t < 4; ++t) *(LAS f32x4*)(red + (rg * 4 + t) * 512 + cgi * 4) = oa[t];
    __syncthreads();
    const int t = rg;
    f32x4 o4 = *(const LAS f32x4*)(red + (0 * 4 + t) * 512 + cgi * 4);
#pragma unroll
    for (int r = 1; r < 4; ++r) o4 += *(const LAS f32x4*)(red + (r * 4 + t) * 512 + cgi * 4);
#pragma unroll
    for (int e = 0; e < 4; ++e) o4 += v[e] * sc[t * 4 + e];
    float s = (o4[0] + o4[1]) + (o4[2] + o4[3]);
#pragma unroll
    for (int m = 1; m < 64; m <<= 1) s += __shfl_xor(s, m);
    if (lane == 0) gs[wid] = s;
    __syncthreads();
    const float mean = (gs[2 * t] + gs[2 * t + 1]) * (1.0f / 512.0f);
    const f32x4 dv = o4 - mean;
    float qv = (dv[0] * dv[0] + dv[1] * dv[1]) + (dv[2] * dv[2] + dv[3] * dv[3]);
#pragma unroll
    for (int m = 1; m < 64; m <<= 1) qv += __shfl_xor(qv, m);
    if (lane == 0) gs[8 + wid] = qv;
    __syncthreads();
    const float rstd = rsqrtf((gs[8 + 2 * t] + gs[8 + 2 * t + 1]) * (1.0f / 512.0f) + 1e-6f);
    const int row = MP + b * 4 + t, col = hd * 512 + cgi * 4;
    const f32x4 gg = *(const f32x4*)(p.ret_gn_g + col);
    const u32x2 sw = *(const u32x2*)((const bf16_t*)(ws + WS_ACT + A_SG) + (size_t)row * 2048 + col);
    const f32x4 sgv = {bflo(sw[0]), bfhi(sw[0]), bflo(sw[1]), bfhi(sw[1])};
    const f32x4 y = dv * rstd * gg * sgv;
    u32x2 w; w[0] = pk_bf16(y[0], y[1]); w[1] = pk_bf16(y[2], y[3]);
    *(u32x2*)((bf16_t*)(ws + WS_ACT + A_OG) + (size_t)row * 2048 + col) = w;
    __syncthreads();
}

__device__ __forceinline__ void phase_gn(const Params& p) {
    unsigned char* ws = p.ws;
    const int tid = otid(), wid = tid >> 6, lane = tid & 63;
    const bf16_t* o = (const bf16_t*)(ws + WS_ACT + A_O); const bf16_t* sg = (const bf16_t*)(ws + WS_ACT + A_SG); bf16_t* og = (bf16_t*)(ws + WS_ACT + A_OG);
    const int nb = gridDim.x == 256 ? 248 : (int)gridDim.x;
    for (int t0 = (p.vb * 8 + wid) * 4; t0 < MP * 4; t0 += nb * 32) {
        u32x4 ow[4], sw[4]; size_t off[4];
#pragma unroll
        for (int r = 0; r < 4; ++r) { const int t = t0 + r; off[r] = (size_t)(t >> 2) * 2048 + (t & 3) * 512 + lane * 8; ow[r] = *(const u32x4*)(o + off[r]); sw[r] = *(const u32x4*)(sg + off[r]); }
#pragma unroll
        for (int r = 0; r < 4; ++r) {
            const int hd = (t0 + r) & 3;
            float x[8];
#pragma unroll
            for (int i = 0; i < 4; ++i) { x[2 * i] = bflo(ow[r][i]); x[2 * i + 1] = bfhi(ow[r][i]); }
            float s = 0.f;
#pragma unroll
            for (int i = 0; i < 8; ++i) s += x[i];
#pragma unroll
            for (int m = 1; m < 64; m <<= 1) s += __shfl_xor(s, m);
            const float mean = s * (1.0f / 512.0f);
            float q = 0.f;
#pragma unroll
            for (int i = 0; i < 8; ++i) { x[i] -= mean; q += x[i] * x[i]; }
#pragma unroll
            for (int m = 1; m < 64; m <<= 1) q += __shfl_xor(q, m);
            const float rstd = rsqrtf(q * (1.0f / 512.0f) + 1e-6f);
            const f32x4 g0 = *(const f32x4*)(p.ret_gn_g + hd * 512 + lane * 8), g1 = *(const f32x4*)(p.ret_gn_g + hd * 512 + lane * 8 + 4);
            u32x4 w;
#pragma unroll
            for (int i = 0; i < 4; ++i) {
                const float ga = i < 2 ? g0[2 * i] : g1[2 * i - 4], gb = i < 2 ? g0[2 * i + 1] : g1[2 * i - 3];
                w[i] = pk_bf16(x[2 * i] * rstd * ga * bflo(sw[r][i]), x[2 * i + 1] * rstd * gb * bfhi(sw[r][i]));
            }
            *(u32x4*)(og + off[r]) = w;
        }
    }
}

__device__ __forceinline__ void rglru_unit(const Params& p, int u, LAS unsigned char* lds) {
    const int tid = otid(), wid = tid >> 6, lane = tid & 63, fr = lane & 15, fq = lane >> 4;
    unsigned char* ws = p.ws;
    constexpr int XA = 0, WA = 43008, WI = 96768, SUM = 150528, HIN = 160768, OUTB = 43008;
    const bool samp = u >= 1024;
    int nb, row_base, chain = 0, cidx = 0;
    if (!samp) { cidx = u >> 6; chain = u & 63; nb = chain & 7; row_base = (chain >> 3) * 2048 + cidx * 128; }
    else { const int su = u - 1024; nb = su & 7; row_base = MP + (su >> 3) * 128; }
    const float* xbr = (const float*)(ws + WS_ACT + A_XBR);
    {
        const bf16_t* wa = (const bf16_t*)(ws + WS_WA) + (size_t)nb * 25600; const bf16_t* wi = (const bf16_t*)(ws + WS_WI) + (size_t)nb * 25600;
        u32x4 ra[7], ri[7];
#pragma unroll
        for (int it = 0; it < 7; ++it) { const int i = tid + it * NTHR; if (i < 3200) { ra[it] = *(const u32x4*)(wa + i * 8); ri[it] = *(const u32x4*)(wi + i * 8); } }
#pragma unroll
        for (int it = 0; it < 7; ++it) { const int i = tid + it * NTHR; if (i < 3200) { const int r = i / 20, ch = i % 20;
            *(LAS u32x4*)(lds + WA + r * 336 + ch * 16) = ra[it]; *(LAS u32x4*)(lds + WI + r * 336 + ch * 16) = ri[it]; } }
    }
    if (tid < 480) {
        const int c4 = tid % 40, rg = tid / 40, ch = nb * 160 + c4 * 4, r0 = rg * 11;
        f32x4 xin[14];
#pragma unroll
        for (int j = 0; j < 14; ++j) {
            const int r = r0 + j - 3, row = row_base + r;
            f32x4 x = {0.f, 0.f, 0.f, 0.f};
            if (r < 128) {
                if (!samp) { if ((row_base & 2047) + r >= 0) x = *(const f32x4*)(xbr + (size_t)row * DRNN + ch); }
                else if (r >= 0) x = *(const f32x4*)(xbr + (size_t)row * DRNN + ch);
            }
            xin[j] = x;
        }
        const f32x4 cb = *(const f32x4*)(p.rec_conv_b + ch);
        f32x4 cw[4];
#pragma unroll
        for (int j = 0; j < 4; ++j) cw[j] = *(const f32x4*)(p.rec_conv_w + j * DRNN + ch);
#pragma unroll
        for (int k = 0; k < 11; ++k) {
            const int r = r0 + k;
            if (r < 128) {
                f32x4 a = cb;
                if (!samp) {
#pragma unroll
                    for (int j = 0; j < 4; ++j) a += cw[j] * xin[k + j];
                } else {
                    const int sr = row_base - MP + r, t = sr & 3, bb = sr >> 2;
#pragma unroll
                    for (int j = 0; j < 4; ++j) {
                        const int tj = t + j;
                        f32x4 x = xin[k + j];
                        if (tj < 3) x = *(const f32x4*)(p.state_conv + (size_t)(bb * 3 + tj) * DRNN + ch);
                        a += cw[j] * x;
                    }
                }
                u32x2 w2; w2[0] = pk_bf16(a[0], a[1]); w2[1] = pk_bf16(a[2], a[3]);
                *(LAS u32x2*)(lds + XA + r * 336 + c4 * 8) = w2;
            }
        }
    }
    __syncthreads();
    f32x4 ga[10], gi[10];
#pragma unroll
    for (int n = 0; n < 10; ++n) { ga[n] = (f32x4){0.f, 0.f, 0.f, 0.f}; gi[n] = (f32x4){0.f, 0.f, 0.f, 0.f}; }
#pragma unroll 1
    for (int ks = 0; ks < 5; ++ks) {
        const bf16x8 af = *(const LAS bf16x8*)(lds + XA + (16 * wid + fr) * 336 + ks * 64 + fq * 16);
#pragma unroll
        for (int n = 0; n < 10; ++n) {
            const bf16x8 ba = *(const LAS bf16x8*)(lds + WA + (16 * n + fr) * 336 + ks * 64 + fq * 16);
            const bf16x8 bi = *(const LAS bf16x8*)(lds + WI + (16 * n + fr) * 336 + ks * 64 + fq * 16);
            ga[n] = mfma16(af, ba, ga[n]); gi[n] = mfma16(af, bi, gi[n]);
        }
    }
#pragma unroll
    for (int n = 0; n < 10; ++n) {
        const int ch = 16 * n + fr, gch = nb * 160 + ch;
        const float ba = p.rec_b_a[gch], bi = p.rec_b_i[gch], spl = ((const float*)(ws + WS_SPL))[gch];
        float hinit = 0.f;
        if (samp) hinit = p.state_lru[(size_t)(((row_base - MP) >> 2) + 4 * wid + fq) * DRNN + gch];
        float Ac = 1.f, hc = hinit;
#pragma unroll
        for (int i = 0; i < 4; ++i) {
            const float r = sigmoid_(ga[n][i] + ba), ig = sigmoid_(gi[n][i] + bi);
            const float la = -spl * r, a = __expf(la);
            const float xc = bf2f(*(const LAS bf16_t*)(lds + XA + (16 * wid + 4 * fq + i) * 336 + ch * 2));
            const float uu = __builtin_amdgcn_sqrtf(fmaxf(__builtin_fmaf(-a, a, 1.0f), 0.f)) * (ig * xc);
            hc = a * hc + uu; Ac = a * Ac;
            ga[n][i] = Ac; gi[n][i] = hc;
        }
        asm volatile("" ::: "memory");
    }
    if (samp) {
#pragma unroll
        for (int n = 0; n < 10; ++n) p.out[O_LRUS + (size_t)(((row_base - MP) >> 2) + 4 * wid + fq) * DRNN + nb * 160 + 16 * n + fr] = gi[n][3];
    } else {
#pragma unroll
        for (int n = 0; n < 10; ++n) {
            float Ac = 1.f, hc = 0.f;
#pragma unroll
            for (int g = 0; g < 3; ++g) {
                const float Ag = __shfl(ga[n][3], g * 16 + fr), hg = __shfl(gi[n][3], g * 16 + fr);
                if (g < fq) { hc = Ag * hc + hg; Ac = Ag * Ac; }
            }
#pragma unroll
            for (int i = 0; i < 4; ++i) { gi[n][i] += ga[n][i] * hc; ga[n][i] *= Ac; }
            if (fq == 3) *(LAS f32x2*)(lds + SUM + ((wid * 160) + 16 * n + fr) * 8) = (f32x2){ga[n][3], gi[n][3]};
        }
        __syncthreads();
#pragma unroll
        for (int n = 0; n < 10; ++n) {
            float Ac = 1.f, hc = 0.f;
            for (int w = 0; w < wid; ++w) { const f32x2 sv = *(const LAS f32x2*)(lds + SUM + ((w * 160) + 16 * n + fr) * 8); hc = sv[0] * hc + sv[1]; Ac = sv[0] * Ac; }
#pragma unroll
            for (int i = 0; i < 4; ++i) { gi[n][i] += ga[n][i] * hc; ga[n][i] *= Ac; }
        }
        unsigned* flags = (unsigned*)(ws + WS_FLAGS); float* carry = (float*)(ws + WS_CARRY);
        if (tid < 160) {
            float Ac = 1.f, hc = 0.f;
            for (int w = 0; w < 8; ++w) { const f32x2 sv = *(const LAS f32x2*)(lds + SUM + ((w * 160) + tid) * 8); hc = sv[0] * hc + sv[1]; Ac = sv[0] * Ac; }
            float hin = 0.f;
            if (cidx > 0) {
                while (__hip_atomic_load(flags + (chain * 16 + cidx - 1) * 16, __ATOMIC_RELAXED, __HIP_MEMORY_SCOPE_AGENT) == 0u) __builtin_amdgcn_s_sleep(1);
                hin = __hip_atomic_load(carry + (size_t)(chain * 16 + cidx - 1) * 160 + tid, __ATOMIC_RELAXED, __HIP_MEMORY_SCOPE_AGENT);
            }
            const float hout = hc + Ac * hin;
            __hip_atomic_store(carry + (size_t)(chain * 16 + cidx) * 160 + tid, hout, __ATOMIC_RELAXED, __HIP_MEMORY_SCOPE_AGENT);
            *(LAS float*)(lds + HIN + tid * 4) = hin;
            if (cidx == 15) p.out[O_LRUP + (size_t)(chain >> 3) * DRNN + nb * 160 + tid] = hout;
        }
        asm volatile("s_waitcnt vmcnt(0)" ::: "memory");
        __syncthreads();
        if (tid == 0) __hip_atomic_store(flags + (chain * 16 + cidx) * 16, 1u, __ATOMIC_RELAXED, __HIP_MEMORY_SCOPE_AGENT);
#pragma unroll
        for (int n = 0; n < 10; ++n) { const float hin = *(const LAS float*)(lds + HIN + (16 * n + fr) * 4);
#pragma unroll
            for (int i = 0; i < 4; ++i) gi[n][i] += ga[n][i] * hin; }
    }
    __syncthreads();
#pragma unroll
    for (int n = 0; n < 10; ++n)
#pragma unroll
        for (int i = 0; i < 4; ++i) *(LAS float*)(lds + OUTB + ((16 * wid + 4 * fq + i) * 164 + 16 * n + fr) * 4) = gi[n][i];
    __syncthreads();
    {
        const bf16_t* gate = (const bf16_t*)(ws + WS_ACT + A_GATE); bf16_t* hg = (bf16_t*)(ws + WS_ACT + A_HG);
        for (int e = tid; e < 128 * 20; e += NTHR) {
            const int r = e / 20, c8 = e % 20; const size_t off = (size_t)(row_base + r) * DRNN + nb * 160 + c8 * 8;
            const u32x4 gw = *(const u32x4*)(gate + off);
            const f32x4 h0 = *(const LAS f32x4*)(lds + OUTB + (r * 164 + c8 * 8) * 4), h1 = *(const LAS f32x4*)(lds + OUTB + (r * 164 + c8 * 8 + 4) * 4);
            u32x4 w; w[0] = pk_bf16(h0[0] * bflo(gw[0]), h0[1] * bfhi(gw[0])); w[1] = pk_bf16(h0[2] * bflo(gw[1]), h0[3] * bfhi(gw[1]));
            w[2] = pk_bf16(h1[0] * bflo(gw[2]), h1[1] * bfhi(gw[2])); w[3] = pk_bf16(h1[2] * bflo(gw[3]), h1[3] * bfhi(gw[3]));
            *(u32x4*)(hg + off) = w;
        }
    }
    __syncthreads();
}

__device__ __forceinline__ void phase_final_ln(const Params& p) {
    const int tid = otid(), wid = tid >> 6, lane = tid & 63;
    const bf16_t* xb = (const bf16_t*)(p.ws + WS_XB16);
    const float* g = p.ln_g + 5 * DM; const float* b = p.ln_b + 5 * DM;
    for (int row = p.vb * 8 + wid; row < MT; row += gridDim.x * 8) {
        float x[16]; float s = 0.f;
#pragma unroll
        for (int k = 0; k < 2; ++k) { const u32x4 w = *(const u32x4*)(xb + (size_t)row * DM + k * 512 + lane * 8);
#pragma unroll
            for (int i = 0; i < 4; ++i) { x[k * 8 + 2 * i] = bflo(w[i]); x[k * 8 + 2 * i + 1] = bfhi(w[i]); } }
#pragma unroll
        for (int i = 0; i < 16; ++i) s += x[i];
#pragma unroll
        for (int m = 1; m < 64; m <<= 1) s += __shfl_xor(s, m);
        const float mean = s * (1.0f / 1024.0f); float q = 0.f;
#pragma unroll
        for (int i = 0; i < 16; ++i) { x[i] -= mean; q += x[i] * x[i]; }
#pragma unroll
        for (int m = 1; m < 64; m <<= 1) q += __shfl_xor(q, m);
        const float rstd = rsqrtf(q * (1.0f / 1024.0f) + 1e-5f);
#pragma unroll
        for (int k = 0; k < 2; ++k)
#pragma unroll
            for (int h2 = 0; h2 < 2; ++h2) { const int col = k * 512 + lane * 8 + h2 * 4;
                const f32x4 xv = {x[k * 8 + h2 * 4], x[k * 8 + h2 * 4 + 1], x[k * 8 + h2 * 4 + 2], x[k * 8 + h2 * 4 + 3]};
                *(f32x4*)(p.out + O_Y + (size_t)row * DM + col) = xv * rstd * *(const f32x4*)(g + col) + *(const f32x4*)(b + col); }
    }
}

constexpr int N_PHASES = 17;
__device__ __forceinline__ void grid_barrier(const Params& p, unsigned k) {
    asm volatile("s_waitcnt vmcnt(0)" ::: "memory");
    __syncthreads();
    if (p.wv == 0) {
        unsigned* bar = (unsigned*)(p.ws + WS_BAR);
        if (p.nloc == 0) {
            __builtin_amdgcn_fence(__ATOMIC_RELEASE, "agent");
            asm volatile("s_waitcnt vmcnt(0)" ::: "memory");
            const unsigned target = (k + 1u) * gridDim.x;
            if (__builtin_amdgcn_mbcnt_hi(~0u, __builtin_amdgcn_mbcnt_lo(~0u, 0u)) == 0u) {
                __hip_atomic_fetch_add(bar, 1u, __ATOMIC_RELAXED, __HIP_MEMORY_SCOPE_AGENT);
                while (__hip_atomic_load(bar, __ATOMIC_RELAXED, __HIP_MEMORY_SCOPE_AGENT) < target) __builtin_amdgcn_s_sleep(2);
            }
            __builtin_amdgcn_fence(__ATOMIC_ACQUIRE, "agent");
            asm volatile("s_waitcnt vmcnt(0)" ::: "memory");
        } else {
            const unsigned nloc = (unsigned)p.nloc, nx = (unsigned)p.nx, x = (unsigned)p.xcc;
            unsigned old = 0;
            if (__builtin_amdgcn_mbcnt_hi(~0u, __builtin_amdgcn_mbcnt_lo(~0u, 0u)) == 0u) old = __hip_atomic_fetch_add(bar + 128 + 16 * x, 1u, __ATOMIC_RELAXED, __HIP_MEMORY_SCOPE_AGENT);
            old = (unsigned)__builtin_amdgcn_readfirstlane((int)old);
            const unsigned gen = old / nloc;
            if (old + 1u == (gen + 1u) * nloc) {
                __builtin_amdgcn_fence(__ATOMIC_RELEASE, "agent");
                asm volatile("s_waitcnt vmcnt(0)" ::: "memory");
                unsigned og = 0;
                if (__builtin_amdgcn_mbcnt_hi(~0u, __builtin_amdgcn_mbcnt_lo(~0u, 0u)) == 0u) og = __hip_atomic_fetch_add(bar + 384, 1u, __ATOMIC_RELAXED, __HIP_MEMORY_SCOPE_AGENT);
                og = (unsigned)__builtin_amdgcn_readfirstlane((int)og);
                const unsigned tg = og / nx;
                if (og + 1u == (tg + 1u) * nx) { if (__builtin_amdgcn_mbcnt_hi(~0u, __builtin_amdgcn_mbcnt_lo(~0u, 0u)) == 0u) __hip_atomic_fetch_add(bar + 400, 1u, __ATOMIC_RELAXED, __HIP_MEMORY_SCOPE_AGENT); }
                else { while (__hip_atomic_load(bar + 400, __ATOMIC_RELAXED, __HIP_MEMORY_SCOPE_AGENT) == tg) __builtin_amdgcn_s_sleep(1); }
                __builtin_amdgcn_fence(__ATOMIC_ACQUIRE, "agent");
                if (__builtin_amdgcn_mbcnt_hi(~0u, __builtin_amdgcn_mbcnt_lo(~0u, 0u)) == 0u) __hip_atomic_fetch_add(bar + 256 + 16 * x, 1u, __ATOMIC_RELAXED, __HIP_MEMORY_SCOPE_AGENT);
                asm volatile("s_waitcnt vmcnt(0)" ::: "memory");
            } else {
                while (__hip_atomic_load(bar + 256 + 16 * x, __ATOMIC_RELAXED, __HIP_MEMORY_SCOPE_AGENT) == gen) __builtin_amdgcn_s_sleep(1);
                __builtin_amdgcn_fence(__ATOMIC_ACQUIRE, "agent");
                asm volatile("s_waitcnt vmcnt(0)" ::: "memory");
            }
        }
    }
    __syncthreads();
}
#define ST(i) ((float*)(ws + WS_STATS) + (size_t)(i) * (SZ_STATS / 4))
__device__ __forceinline__ EpiOut make_epi_ffn_out(const Params& p, int ph) {
    unsigned char* ws = p.ws;
    const int stp = ph == 8 ? 1 : ph == 10 ? 2 : 4, stn = ph == 2 ? 0 : ph == 8 ? 2 : ph == 10 ? 3 : 5;
    const int lni = ph == 8 ? 1 : ph == 10 ? 2 : 4;
    return EpiOut{(float*)(ws + WS_PRE), (bf16_t*)(ws + WS_XB16), ST(stp), ST(stn), p.ln_g + lni * DM, p.ln_b + lni * DM, p.x_prompt, p.x_sample, 0.5f, ph == 2};
}
__device__ __forceinline__ size_t ffn_out_w(int ph) { return ph == 2 ? WS_WF1OUT0 : ph == 8 ? WS_WF2OUT0 : ph == 10 ? WS_WF1OUT1 : WS_WF2OUT1; }
__device__ __forceinline__ void run_ffn_in(const Params& p, LAS unsigned char* lds, int ph) {
    unsigned char* ws = p.ws;
    const int layer = ph >= 9, second = (ph == 7 || ph == 14);
    const size_t wo = layer == 0 ? (second ? WS_WF2IN0 : WS_WF1IN0) : (second ? WS_WF2IN1 : WS_WF1IN1);
    const size_t co = ph == 7 ? WS_C_F2IN0 : ph == 9 ? WS_C_F1IN1 : WS_C_F2IN1;
    const int sti = ph == 7 ? 1 : ph == 9 ? 2 : 4;
    const bool special = gridDim.x == 256;
    unsigned* ctr = (unsigned*)(ws + WS_BAR) + 16 * (1 + (ph == 1 ? 0 : ph == 7 ? 1 : ph == 9 ? 2 : 3));
    Sched S; S.c = p.vb; S.init(ws + WS_XB16, ws + wo, MT, NFF, DM, 0); if (special) S.mode = 1;
    EpiFfnIn E{(bf16_t*)(ws + WS_ACT + A_H), ST(sti), (const float*)(ws + co), (const float*)(ws + co) + NFF, ph != 1};
    gemm_phase<false>(lds, S, E, p.wv, special ? ctr : nullptr);
    if (special && ph == 1 && p.vb >= 188 && p.vb < 248) phase_prep(p, lds, 3, p.vb - 188, 60);
    if (special && p.vb >= 248) {
        if (p.wv == 0) { while (__hip_atomic_load(ctr, __ATOMIC_RELAXED, __HIP_MEMORY_SCOPE_AGENT) < 44u * 8u) __builtin_amdgcn_s_sleep(8); }
        __syncthreads();
        __builtin_amdgcn_fence(__ATOMIC_ACQUIRE, "agent");
        asm volatile("s_waitcnt vmcnt(0)" ::: "memory");
        const int su = p.vb - 248;
        Sched S2; S2.c = p.vb; S2.init(ws + WS_ACT + A_H, ws + ffn_out_w(ph + 1), MT, DM, DFF, 0); S2.mode = 2; S2.upm = 64 + (su >> 2); S2.upn = su & 3;
        const EpiOut E2 = make_epi_ffn_out(p, ph + 1);
        gemm_phase<false>(lds, S2, E2, p.wv);
    }
}
__device__ __forceinline__ void run_ffn_out(const Params& p, LAS unsigned char* lds, int ph) {
    unsigned char* ws = p.ws;
    const bool special = gridDim.x == 256;
    Sched S; S.c = p.vb; S.init(ws + WS_ACT + A_H, ws + ffn_out_w(ph), special ? MP : MT, DM, DFF, 0);
    const EpiOut E = make_epi_ffn_out(p, ph);
    gemm_phase<false>(lds, S, E, p.wv);
}
__device__ __forceinline__ void run_mix_out(const Params& p, LAS unsigned char* lds, int ph, int M_rows, int only_sample_unit) {
    unsigned char* ws = p.ws;
    const bool ret = ph == 6;
    Sched S; S.c = p.vb; S.init(ws + WS_ACT + (ret ? A_OG : A_HG), ws + (ret ? WS_WRETOUT : WS_WRECOUT), M_rows, DM, ret ? RV : DRNN, 0);
    if (only_sample_unit >= 0) { S.mode = 2; S.upm = 64 + (only_sample_unit >> 2); S.upn = only_sample_unit & 3; }
    const int lni = ret ? 0 : 3;
    EpiOut E{(float*)(ws + WS_PRE), (bf16_t*)(ws + WS_XB16), ST(lni), ST(lni + 1), p.ln_g + lni * DM, p.ln_b + lni * DM, p.x_prompt, p.x_sample, 1.0f, 0};
    gemm_phase<false>(lds, S, E, p.wv);
}

__global__ void __launch_bounds__(NTHR) fwd_megakernel(Params p_) {
    Params p = p_; p.wv = __builtin_amdgcn_readfirstlane((int)(threadIdx.x >> 6));
    extern __shared__ __attribute__((aligned(16))) unsigned char lds_raw[];
    LAS unsigned char* lds = (LAS unsigned char*)lds_raw;
    const int lo = (int)p.ph_lo, hi = (int)p.ph_hi;
    p.vb = (int)blockIdx.x; p.xcc = 0; p.nloc = 0; p.nx = 0;
    if (hi - lo > 1) {
        unsigned* cen = (unsigned*)(p.ws + WS_BAR) + 96;
        const unsigned xcc = (unsigned)__builtin_amdgcn_s_getreg((3 << 11) | 20) & 0xFu;
        unsigned rank = 0;
        if (threadIdx.x == 0) rank = __hip_atomic_fetch_add(cen + (xcc & 7u), 1u, __ATOMIC_RELAXED, __HIP_MEMORY_SCOPE_AGENT);
        rank = (unsigned)__builtin_amdgcn_readfirstlane((int)rank);
        cg::this_grid().sync();
        bool ok = gridDim.x == 256 && xcc < 8u;
#pragma unroll
        for (int j = 0; j < 8; ++j) ok = ok && (__hip_atomic_load(cen + j, __ATOMIC_RELAXED, __HIP_MEMORY_SCOPE_AGENT) == 32u);
        LAS unsigned* sh = (LAS unsigned*)lds;
        if (threadIdx.x == 0) sh[0] = rank;
        __syncthreads();
        const unsigned r0 = sh[0];
        __syncthreads();
        if (ok) { p.vb = __builtin_amdgcn_readfirstlane((int)(r0 * 8u + xcc)); p.xcc = (int)xcc; p.nloc = 32; p.nx = 8; }
    }
    unsigned bk = 0;
#define PHASE(ph, ...) if (lo <= (ph) && (ph) < hi) { __VA_ARGS__; if ((ph) + 1 < hi) grid_barrier(p, bk++); }
    PHASE(0, phase_prep(p, lds, gridDim.x == 256 ? 1 : 0, p.vb, (int)gridDim.x))
    PHASE(1, run_ffn_in(p, lds, 1))
    PHASE(2, run_ffn_out(p, lds, 2))
    PHASE(3, { unsigned char* ws = p.ws; const bool special = gridDim.x == 256; unsigned* ctr = (unsigned*)(ws + WS_BAR) + 80;
               Sched S; S.c = p.vb; S.init(ws + WS_XB16, ws + WS_WRETIN, MT, NRET, DM, 0); if (special) S.mode = 3; EpiRetIn E{ws};
               if (!special) gemm_phase<true>(lds, S, E, p.wv, nullptr);
               else {
                   const int rb = 1 + (p.vb % 6);
                   S.iend = rb; gemm_phase<true>(lds, S, E, p.wv, ctr);
                   if (p.wv == 0) { while (__hip_atomic_load(ctr, __ATOMIC_RELAXED, __HIP_MEMORY_SCOPE_AGENT) < 48u * 8u) __builtin_amdgcn_s_sleep(8);
                                    __builtin_amdgcn_fence(__ATOMIC_ACQUIRE, "agent"); asm volatile("s_waitcnt vmcnt(0)" ::: "memory"); }
                   __syncthreads();
                   for (int su = p.vb; su < 512; su += 256) ret_sample_unit<8>(p, su, lds);
                   S.ibase = rb; S.iend = 1 << 20; gemm_phase<true>(lds, S, E, p.wv, ctr);
                   if (p.vb >= 48) phase_prep(p, lds, 2, p.vb - 48, 208);
               } })
    PHASE(4, { const int nu = gridDim.x == 256 ? 256 : 768; for (int u = p.vb; u < nu; u += gridDim.x) { if (u < 256) ret_prompt_unit(p, u, lds); else ret_sample_unit<4>(p, u - 256, lds); } })
    PHASE(5, { if (gridDim.x == 256 && p.vb >= 248) run_mix_out(p, lds, 6, MT, p.vb - 248); else phase_gn(p); })
    PHASE(6, run_mix_out(p, lds, 6, gridDim.x == 256 ? MP : MT, -1))
    PHASE(7, run_ffn_in(p, lds, 7))
    PHASE(8, run_ffn_out(p, lds, 8))
    PHASE(9, run_ffn_in(p, lds, 9))
    PHASE(10, run_ffn_out(p, lds, 10))
    PHASE(11, { unsigned char* ws = p.ws; const bool special = gridDim.x == 256; unsigned* ctr = (unsigned*)(ws + WS_BAR) + 112;
                Sched S; S.c = p.vb; S.init(ws + WS_XB16, ws + WS_WRECIN, MT, NREC, DM, 0); if (special) S.mode = 4;
                EpiRecIn E{(bf16_t*)(ws + WS_ACT + A_GATE), (float*)(ws + WS_ACT + A_XBR), p.out, ST(3), (const float*)(ws + WS_C_RECIN), (const float*)(ws + WS_C_RECIN) + NREC};
                gemm_phase<false>(lds, S, E, p.wv, special ? ctr : nullptr);
                if (special && p.vb >= 224) {
                    if (p.wv == 0) { while (__hip_atomic_load(ctr, __ATOMIC_RELAXED, __HIP_MEMORY_SCOPE_AGENT) < 20u * 8u) __builtin_amdgcn_s_sleep(8);
                                     __builtin_amdgcn_fence(__ATOMIC_ACQUIRE, "agent"); asm volatile("s_waitcnt vmcnt(0)" ::: "memory"); }
                    __syncthreads();
                    rglru_unit(p, 1024 + (p.vb - 224), lds);
                } })
    PHASE(12, { if (gridDim.x != 256) { for (int u = p.vb; u < 1056; u += gridDim.x) rglru_unit(p, u, lds); }
                else if (p.vb >= 248) { run_mix_out(p, lds, 13, MT, p.vb - 248); rglru_unit(p, p.vb + 512, lds); rglru_unit(p, p.vb + 768, lds); }
                else {
                    for (int sl = 0; sl < 5; ++sl) {
                        int u;
                        if (p.vb < 8) u = sl == 0 ? 248 + p.vb : p.vb + 256 * (sl - 1);
                        else if (p.vb < 16) u = sl == 0 ? p.vb : (sl == 1 ? 248 + (p.vb - 8) + 256 : p.vb + 256 * (sl - 1));
                        else u = sl < 4 ? p.vb + 256 * sl : -1;
                        if (u >= 0) rglru_unit(p, u, lds);
                    }
                } })
    PHASE(13, run_mix_out(p, lds, 13, gridDim.x == 256 ? MP : MT, -1))
    PHASE(14, run_ffn_in(p, lds, 14))
    PHASE(15, run_ffn_out(p, lds, 15))
    PHASE(16, phase_final_ln(p))
#undef PHASE
}
#undef ST

extern "C" void kernel_launch(void* const* d_in, const int* in_sizes, int n_in, void* d_out, int out_size, void* d_ws, size_t ws_size, hipStream_t stream) {
    static int grid = 0;
    if (grid == 0) {
        if (n_in != 23 || ws_size < WS_END) { fprintf(stderr, "kernel_launch: unexpected n_in %d or ws_size %zu (< %zu)\n", n_in, ws_size, (size_t)WS_END); grid = -1; return; }
        int dev = 0, cus = 0, per_cu = 0;
        hipGetDevice(&dev);
        hipDeviceGetAttribute(&cus, hipDeviceAttributeMultiprocessorCount, dev);
        if (hipFuncSetAttribute((const void*)fwd_megakernel, hipFuncAttributeMaxDynamicSharedMemorySize, LDS_BYTES) != hipSuccess) { fprintf(stderr, "kernel_launch: hipFuncSetAttribute failed\n"); grid = -1; return; }
        if (hipOccupancyMaxActiveBlocksPerMultiprocessor(&per_cu, (const void*)fwd_megakernel, NTHR, LDS_BYTES) != hipSuccess || per_cu < 1) { fprintf(stderr, "kernel_launch: occupancy query failed (%d)\n", per_cu); per_cu = 1; }
        (void)hipGetLastError();
        grid = cus * per_cu;
    }
    if (grid < 0) return;
    Params p{};
    const float** pp = (const float**)&p;
    for (int i = 0; i < 23; ++i) pp[i] = (const float*)d_in[i];
    p.out = (float*)d_out; p.ws = (unsigned char*)d_ws;
#if PER_PHASE_LAUNCH
    for (int ph = 0; ph < N_PHASES; ++ph) { p.ph_lo = ph; p.ph_hi = ph + 1; hipLaunchKernelGGL(fwd_megakernel, dim3(grid), dim3(NTHR), LDS_BYTES, stream, p); }
#else
    p.ph_lo = 0; p.ph_hi = N_PHASES;
    if (hipMemsetAsync((char*)d_ws + WS_BAR, 0, 2048, stream) != hipSuccess) { fprintf(stderr, "kernel_launch: memset of the barrier word failed\n"); return; }
    void* args[] = {&p};
    hipError_t e = hipLaunchCooperativeKernel((const void*)fwd_megakernel, dim3(grid), dim3(NTHR), args, LDS_BYTES, stream);
    if (e != hipSuccess) fprintf(stderr, "cooperative launch failed: %s (grid %d)\n", hipGetErrorString(e), grid);
#endif
}
```
